# Optimizing an MI355X kernel written in HIP

```python
import math
import jax, jax.numpy as jnp
from jax import lax
import numpy as np

D_MODEL = 1024
BATCH = 8
SEQ = 2048
DEPTH = 1
DEC_BATCH = 128
DEC_SEQ = 1
PAST_LEN = 16384
PAGE_SIZE = 128

MIX_WIDTH = D_MODEL
SSM_WIDTH = MIX_WIDTH // 2
CONV_WIDTH = MIX_WIDTH - SSM_WIDTH
SSM_GROUP = 16
N_SSM_GROUPS = SSM_WIDTH // SSM_GROUP
SSM_STATE = 64
CONV_K = 3
CONV_HEADS = 8
D_FF = 2816
IN_PROJ_WIDTH = SSM_WIDTH + 3 * CONV_WIDTH
EPS = 1e-6
DT_MIN = 1e-3
DT_MAX = 1e-1

kernel_name = "hymba_s5_shortconv_macaron_step"


def rmsnorm(x, g):
    xf = x.astype(jnp.float32)
    r = lax.rsqrt(jnp.mean(xf * xf, axis=-1, keepdims=True) + EPS)
    return (xf * r * g.astype(jnp.float32)).astype(x.dtype)


def swiglu(x, w_gate, w_up, w_down):
    return (jax.nn.silu(x @ w_gate) * (x @ w_up)) @ w_down


def s5_discretize(lam_re, lam_im, log_dt, b_re, b_im):
    f32 = jnp.float32
    dt = jnp.exp(log_dt.astype(f32))[:, None]
    lr = lam_re.astype(f32)
    li = lam_im.astype(f32)
    mag = jnp.exp(lr * dt)
    ab_re = mag * jnp.cos(li * dt)
    ab_im = mag * jnp.sin(li * dt)
    den = lr * lr + li * li
    nr = ab_re - 1.0
    ni = ab_im
    coef_re = ((nr * lr + ni * li) / den)[..., None]
    coef_im = ((ni * lr - nr * li) / den)[..., None]
    br = b_re.astype(f32)
    bi = b_im.astype(f32)
    bb_re = coef_re * br - coef_im * bi
    bb_im = coef_re * bi + coef_im * br
    return ab_re, ab_im, bb_re, bb_im


def _complex_affine_combine(e1, e2):
    a1r, a1i, b1r, b1i = e1
    a2r, a2i, b2r, b2i = e2
    return (a1r * a2r - a1i * a2i,
            a1r * a2i + a1i * a2r,
            a2r * b1r - a2i * b1i + b2r,
            a2r * b1i + a2i * b1r + b2i)


def s5_mixer(u, h0_re, h0_im, lam_re, lam_im, log_dt, b_re, b_im, c_re, c_im, d_skip, w_glu, b_glu):
    f32 = jnp.float32
    bsz, seq_len, _ = u.shape
    uf = u.astype(f32)
    ug = uf.reshape(bsz, seq_len, N_SSM_GROUPS, SSM_GROUP)
    ab_re, ab_im, bb_re, bb_im = s5_discretize(lam_re, lam_im, log_dt, b_re, b_im)
    bu_re = jnp.einsum('blgc,gpc->blgp', ug, bb_re)
    bu_im = jnp.einsum('blgc,gpc->blgp', ug, bb_im)
    h0r = h0_re.astype(f32)
    h0i = h0_im.astype(f32)
    bu_re = bu_re.at[:, 0].add(ab_re * h0r - ab_im * h0i)
    bu_im = bu_im.at[:, 0].add(ab_re * h0i + ab_im * h0r)
    a_re = jnp.broadcast_to(ab_re, bu_re.shape)
    a_im = jnp.broadcast_to(ab_im, bu_im.shape)
    _, _, x_re, x_im = lax.associative_scan(_complex_affine_combine, (a_re, a_im, bu_re, bu_im), axis=1)
    y = (jnp.einsum('blgp,gcp->blgc', x_re, c_re.astype(f32))
         - jnp.einsum('blgp,gcp->blgc', x_im, c_im.astype(f32)))
    y = y.reshape(bsz, seq_len, SSM_WIDTH) + d_skip.astype(f32) * uf
    z = jax.nn.gelu(y)
    out = z * jax.nn.sigmoid(z @ w_glu.astype(f32) + b_glu.astype(f32))
    return out.astype(u.dtype), x_re[:, -1], x_im[:, -1]


def short_conv_mixer(x_in, gate_b, gate_c, buf, conv_w):
    seq_len = x_in.shape[1]
    v = gate_c * x_in
    vp = jnp.concatenate([buf.astype(v.dtype), v], axis=1)
    z = conv_w[0] * vp[:, 0:seq_len]
    for k in range(1, CONV_K):
        z = z + conv_w[k] * vp[:, k:k + seq_len]
    return gate_b * z, vp[:, -(CONV_K - 1):]


def decoder_layer(x, h_re, h_im, conv_buf,
                  ffn1_norm, ffn1_w_gate, ffn1_w_up, ffn1_w_down,
                  mix_norm, w_in,
                  ssm_lambda_re, ssm_lambda_im, ssm_log_dt, ssm_b_re, ssm_b_im,
                  ssm_c_re, ssm_c_im, ssm_d, ssm_w_glu, ssm_b_glu,
                  conv_w, w_out,
                  ffn2_norm, ffn2_w_gate, ffn2_w_up, ffn2_w_down):
    h = x + 0.5 * swiglu(rmsnorm(x, ffn1_norm), ffn1_w_gate, ffn1_w_up, ffn1_w_down)
    p = rmsnorm(h, mix_norm) @ w_in
    u = p[..., :SSM_WIDTH]
    x_conv = p[..., SSM_WIDTH:SSM_WIDTH + CONV_WIDTH]
    gate_b = p[..., SSM_WIDTH + CONV_WIDTH:SSM_WIDTH + 2 * CONV_WIDTH]
    gate_c = p[..., SSM_WIDTH + 2 * CONV_WIDTH:]
    s_out, new_re, new_im = s5_mixer(u, h_re, h_im, ssm_lambda_re, ssm_lambda_im, ssm_log_dt,
                                     ssm_b_re, ssm_b_im, ssm_c_re, ssm_c_im, ssm_d, ssm_w_glu, ssm_b_glu)
    c_out, new_buf = short_conv_mixer(x_conv, gate_b, gate_c, conv_buf, conv_w)
    h = h + jnp.concatenate([s_out, c_out.astype(s_out.dtype)], axis=-1) @ w_out
    h = h + 0.5 * swiglu(rmsnorm(h, ffn2_norm), ffn2_w_gate, ffn2_w_up, ffn2_w_down)
    return h, new_re, new_im, new_buf


def setup_inputs(seed: int = 0) -> dict:
    key = jax.random.key(seed)
    ks = jax.random.split(key, 40)
    f32 = jnp.float32

    def nrm(k, shape, scale):
        return scale * jax.random.normal(k, shape, f32)

    n_idx = jnp.arange(SSM_STATE, dtype=f32)
    gp = (DEPTH, N_SSM_GROUPS, SSM_STATE)
    return {
        "x_prompt": nrm(ks[0], (BATCH, SEQ, D_MODEL), 1.0),
        "x_sample": nrm(ks[1], (DEC_BATCH, DEC_SEQ, D_MODEL), 1.0),
        "state_ssm_re": nrm(ks[2], (DEPTH, DEC_BATCH, N_SSM_GROUPS, SSM_STATE), 0.1),
        "state_ssm_im": nrm(ks[3], (DEPTH, DEC_BATCH, N_SSM_GROUPS, SSM_STATE), 0.1),
        "state_conv": nrm(ks[4], (DEPTH, DEC_BATCH, CONV_K - 1, CONV_WIDTH), 1.0),
        "ffn1_norm": 1.0 + nrm(ks[5], (DEPTH, D_MODEL), 0.02),
        "ffn1_w_gate": nrm(ks[6], (DEPTH, D_MODEL, D_FF), D_MODEL ** -0.5),
        "ffn1_w_up": nrm(ks[7], (DEPTH, D_MODEL, D_FF), D_MODEL ** -0.5),
        "ffn1_w_down": nrm(ks[8], (DEPTH, D_FF, D_MODEL), D_FF ** -0.5),
        "mix_norm": 1.0 + nrm(ks[9], (DEPTH, D_MODEL), 0.02),
        "w_in": nrm(ks[10], (DEPTH, D_MODEL, IN_PROJ_WIDTH), D_MODEL ** -0.5),
        "ssm_lambda_re": -0.5 + nrm(ks[11], gp, 0.01),
        "ssm_lambda_im": math.pi * n_idx + nrm(ks[12], gp, 0.01),
        "ssm_log_dt": jax.random.uniform(ks[13], (DEPTH, N_SSM_GROUPS), f32,
                                         minval=math.log(DT_MIN), maxval=math.log(DT_MAX)),
        "ssm_b_re": nrm(ks[14], (DEPTH, N_SSM_GROUPS, SSM_STATE, SSM_GROUP), (2 * SSM_GROUP) ** -0.5),
        "ssm_b_im": nrm(ks[15], (DEPTH, N_SSM_GROUPS, SSM_STATE, SSM_GROUP), (2 * SSM_GROUP) ** -0.5),
        "ssm_c_re": nrm(ks[16], (DEPTH, N_SSM_GROUPS, SSM_GROUP, SSM_STATE), SSM_STATE ** -0.5),
        "ssm_c_im": nrm(ks[17], (DEPTH, N_SSM_GROUPS, SSM_GROUP, SSM_STATE), SSM_STATE ** -0.5),
        "ssm_d": nrm(ks[18], (DEPTH, SSM_WIDTH), 1.0),
        "ssm_w_glu": nrm(ks[19], (DEPTH, SSM_WIDTH, SSM_WIDTH), SSM_WIDTH ** -0.5),
        "ssm_b_glu": nrm(ks[20], (DEPTH, SSM_WIDTH), 0.02),
        "conv_w": nrm(ks[21], (DEPTH, CONV_K, CONV_WIDTH), CONV_K ** -0.5),
        "w_out": nrm(ks[22], (DEPTH, MIX_WIDTH, D_MODEL), MIX_WIDTH ** -0.5),
        "ffn2_norm": 1.0 + nrm(ks[23], (DEPTH, D_MODEL), 0.02),
        "ffn2_w_gate": nrm(ks[24], (DEPTH, D_MODEL, D_FF), D_MODEL ** -0.5),
        "ffn2_w_up": nrm(ks[25], (DEPTH, D_MODEL, D_FF), D_MODEL ** -0.5),
        "ffn2_w_down": nrm(ks[26], (DEPTH, D_FF, D_MODEL), D_FF ** -0.5),
        "final_norm": 1.0 + nrm(ks[27], (D_MODEL,), 0.02),
    }


def reference(x_prompt, x_sample, state_ssm_re, state_ssm_im, state_conv,
              ffn1_norm, ffn1_w_gate, ffn1_w_up, ffn1_w_down,
              mix_norm, w_in,
              ssm_lambda_re, ssm_lambda_im, ssm_log_dt, ssm_b_re, ssm_b_im,
              ssm_c_re, ssm_c_im, ssm_d, ssm_w_glu, ssm_b_glu,
              conv_w, w_out,
              ffn2_norm, ffn2_w_gate, ffn2_w_up, ffn2_w_down,
              final_norm):
    n_prompt = x_prompt.shape[0]
    hp = x_prompt
    hs = x_sample
    p_re, p_im, p_conv, s_re, s_im, s_conv = [], [], [], [], [], []
    for l in range(DEPTH):
        lw = (ffn1_norm[l], ffn1_w_gate[l], ffn1_w_up[l], ffn1_w_down[l],
              mix_norm[l], w_in[l],
              ssm_lambda_re[l], ssm_lambda_im[l], ssm_log_dt[l], ssm_b_re[l], ssm_b_im[l],
              ssm_c_re[l], ssm_c_im[l], ssm_d[l], ssm_w_glu[l], ssm_b_glu[l],
              conv_w[l], w_out[l],
              ffn2_norm[l], ffn2_w_gate[l], ffn2_w_up[l], ffn2_w_down[l])
        zero_h = jnp.zeros((n_prompt, N_SSM_GROUPS, SSM_STATE), jnp.float32)
        zero_buf = jnp.zeros((n_prompt, CONV_K - 1, CONV_WIDTH), x_prompt.dtype)
        hp, r_p, i_p, b_p = decoder_layer(hp, zero_h, zero_h, zero_buf, *lw)
        hs, r_s, i_s, b_s = decoder_layer(hs, state_ssm_re[l], state_ssm_im[l], state_conv[l], *lw)
        p_re.append(r_p); p_im.append(i_p); p_conv.append(b_p)
        s_re.append(r_s); s_im.append(i_s); s_conv.append(b_s)
    y_prompt = rmsnorm(hp, final_norm)
    y_sample = rmsnorm(hs, final_norm)
    new_ssm_re_prompt = jnp.stack(p_re, axis=0)
    new_ssm_im_prompt = jnp.stack(p_im, axis=0)
    new_conv_prompt = jnp.stack(p_conv, axis=0)
    new_ssm_re_sample = jnp.stack(s_re, axis=0)
    new_ssm_im_sample = jnp.stack(s_im, axis=0)
    new_conv_sample = jnp.stack(s_conv, axis=0)
    return (y_prompt, y_sample, new_ssm_re_prompt, new_ssm_im_prompt, new_conv_prompt,
            new_ssm_re_sample, new_ssm_im_sample, new_conv_sample)
```

```cpp
#include <hip/hip_runtime.h>
#include <hip/hip_cooperative_groups.h>
#include <cstdio>
#include <cstdint>
namespace cg = cooperative_groups;

#define LAS __attribute__((address_space(3)))
typedef unsigned short bf16_t;
typedef short bf16x8 __attribute__((ext_vector_type(8)));
typedef float f32x4 __attribute__((ext_vector_type(4)));
typedef float f32x16 __attribute__((ext_vector_type(16)));
typedef unsigned u32x4 __attribute__((ext_vector_type(4)));
typedef unsigned u32x2 __attribute__((ext_vector_type(2)));

constexpr int DM = 1024, NPROMPT = 16384, NSAMP = 128, MROWS = NPROMPT + NSAMP, MP = 16640, DFF = 2816, SEQ = 2048, NBATCH = 8;
constexpr int NG = 32, NS = 64, PW = 2048, SSMW = 512;
constexpr int TCH = 128, NCH = SEQ / TCH;
constexpr float EPS = 1e-6f;
constexpr int NWAVES = 8, NTHREADS = 512;
constexpr int LDS_BYTES = 147456;

constexpr size_t O_REP = (size_t)MROWS * DM, O_IMP = O_REP + 16384, O_CVP = O_IMP + 16384, O_RES = O_CVP + 8192, O_IMS = O_RES + 262144, O_CVS = O_IMS + 262144;

constexpr size_t MiB = 1u << 20;
constexpr size_t WS_SS = 0;
constexpr size_t WS_TAB = 1 * MiB;
constexpr size_t T_AB = 0, T_AB16 = 16384, T_AB128 = 32768, T_BF = 49152, T_CF = T_BF + 131072;
constexpr size_t WS_WGU1 = 4 * MiB, WS_WD1 = WS_WGU1 + 11 * MiB, WS_WIN = WS_WD1 + 5632 * 1024, WS_WGLU = WS_WIN + 4 * MiB, WS_WOUT = WS_WGLU + 512 * 1024,
                 WS_WGU2 = WS_WOUT + 2 * MiB, WS_WD2 = WS_WGU2 + 11 * MiB;
constexpr size_t WS_AB = 44 * MiB;
constexpr size_t WS_ACT = 77 * MiB;
constexpr size_t WS_P = WS_ACT, WS_Z = WS_ACT + 65 * MiB;
constexpr size_t WS_MIX = 167 * MiB;
constexpr size_t WS_E = 200 * MiB;
constexpr size_t WS_PART = 202 * MiB;
constexpr size_t WS_BAR = 768 * 1024;
constexpr size_t WS_CNT = 512 * 1024;
constexpr size_t WS_END = 214 * MiB;

struct Params { const float* in[28]; float* out; unsigned char* ws; };

__device__ __forceinline__ unsigned f2bf(float f) { unsigned u = __builtin_bit_cast(unsigned, f); return (u + 0x7fffu + ((u >> 16) & 1u)) >> 16; }
__device__ __forceinline__ unsigned cvt_pk_bf16(float lo, float hi) { unsigned r; asm("v_cvt_pk_bf16_f32 %0, %1, %2" : "=v"(r) : "v"(lo), "v"(hi)); return r; }
__device__ __forceinline__ unsigned pk2(float lo, float hi) { return cvt_pk_bf16(lo, hi); }
__device__ __forceinline__ float bf2f(unsigned short b) { return __builtin_bit_cast(float, (unsigned)b << 16); }
__device__ __forceinline__ float bflo(unsigned w) { return __builtin_bit_cast(float, w << 16); }
__device__ __forceinline__ float bfhi(unsigned w) { return __builtin_bit_cast(float, w & 0xffff0000u); }
__device__ __forceinline__ float sigmoidf_(float x) { return __builtin_amdgcn_rcpf(1.0f + __builtin_amdgcn_exp2f(-1.4426950408889634f * x)); }
__device__ __forceinline__ float gelu_tanh(float y) { const float v = 0.7978845608028654f * (y + 0.044715f * y * y * y); return y * __builtin_amdgcn_rcpf(1.0f + __builtin_amdgcn_exp2f(-2.8853900817779268f * v)); }
__device__ __forceinline__ float wave_sum(float v) {
#pragma unroll
    for (int o = 1; o < 64; o <<= 1) v += __shfl_xor(v, o);
    return v;
}
#define LDS_WAIT() asm volatile("s_waitcnt lgkmcnt(0)" ::: "memory")

namespace pg8 {
constexpr int BM = 256, BK = 64, HALF = 128, HTB = HALF * BK * 2, STAGE_BYTES = 8 * HTB, NXCD = 8, WGM = 8;
__host__ __device__ __forceinline__ int lds_byte(int r, int c) { const int st = (r >> 4) * 2 + (c >> 5), rr = r & 15, cc = c & 31, ob = rr * 64 + cc * 2; return st * 1024 + (ob ^ (((ob >> 9) & 1) << 5)); }
__host__ __device__ __forceinline__ void stage_rc(int b, int& R, int& C) { const int st = b / 1024, sb = b % 1024, swz = sb ^ (((sb >> 9) & 1) << 5); R = (st >> 1) * 16 + swz / 64; C = (st & 1) * 32 + (swz % 64) / 2; }
__host__ __device__ __forceinline__ int perm32(int rho) { const int n = rho >> 4, i = rho & 15; return 8 * (i >> 2) + 4 * n + (i & 3); }
struct Unit { int pm, pn, k0, nt, split; };
struct Gemm { const bf16_t* A; const bf16_t* Bt; int M, N, K; };
struct SplitOrder {
    int nN, nwgp, nks, ntk, ntf, G, c, which;
    __device__ void init(int N, int K, int nks_, int G_, int c_, int which_ = 0) { nN = N / BM; nwgp = 64 * nN; nks = nks_; ntf = K / BK; ntk = ntf / nks_; G = G_; c = c_; which = which_; }
    __device__ bool next(int i, Unit& u) const {
        int L = i * G + c;
        if (which == 2) { if (L >= nN) return false; u.pm = 64; u.pn = L; u.k0 = 0; u.nt = ntf; u.split = -1; return true; }
        const int nsp = nks > 1 ? nN * nks : 0;
        if (L < nsp) { const int ks = L / nN; u.pm = 64; u.pn = L % nN; u.k0 = ks * ntk; u.nt = ntk; u.split = ks; return true; }
        L -= nsp;
        if (L < nwgp) {
            const int q = nwgp / NXCD, xcd = L % NXCD, off = L / NXCD; const int wgid = xcd * q + off;
            const int nig = WGM * nN, gid = wgid / nig, fm = gid * WGM;
            u.pm = fm + ((wgid % nig) % WGM); u.pn = (wgid % nig) / WGM; u.k0 = 0; u.nt = ntf; u.split = -1; return true;
        }
        if (nks > 1 || which == 1) return false;
        const int j = L - nwgp; if (j >= nN) return false;
        u.pm = 64; u.pn = j; u.k0 = 0; u.nt = ntf; u.split = -1; return true;
    }
};
struct SplitCtx { float* part; unsigned* cnt; int nks; };
template <class Epi, class Sched, bool ALIGN_EPI, bool SP2>
__device__ __forceinline__ void gemm_phase(LAS unsigned char* lds, const Gemm g, const Sched& S, const Epi& E, const SplitCtx sc) {
    int tid_ = threadIdx.x; asm volatile("" : "+v"(tid_));
    const int tid = tid_, wid = __builtin_amdgcn_readfirstlane(tid >> 6), lane = tid & 63, wr = wid >> 2, wc = wid & 3, fr = lane & 15, fq = lane >> 4;
    const int K = g.K;
    unsigned voffA[2], voffB[2];
#pragma unroll
    for (int i = 0; i < 2; ++i) { int R, C; stage_rc(tid * 16 + i * 8192, R, C); const int Rb = Epi::PERM ? ((R & ~31) + perm32(R & 31)) : R;
        voffA[i] = (unsigned)(R * K + C) * 2u; voffB[i] = (unsigned)(Rb * K + C) * 2u; }
    const size_t kstep = (size_t)(BK * 2);
    const size_t hstep = (size_t)HALF * K * 2;
    const size_t tstep = 2 * hstep;
    const unsigned ldsw = (unsigned)wid * 1024u;
    const int aoff = lds_byte(wr * 64 + fr, fq * 8), boff = lds_byte(wc * 32 + fr, fq * 8);
#define PG8_SA(b, h) (((b) * 2 + (h)) * HTB)
#define PG8_SB(b, h) ((4 + (b) * 2 + (h)) * HTB)
#define PG8_STAGE(bufoff, gbase, voff) do { _Pragma("unroll") for (int _i = 0; _i < 2; ++_i) \
        __builtin_amdgcn_global_load_lds((const unsigned*)((const char*)(gbase) + (voff)[_i]), (LAS unsigned*)(lds + (bufoff) + ldsw + _i * 8192), 16, 0, 0); } while (0)
#define PG8_LDA(dst, b, h) do { _Pragma("unroll") for (int m = 0; m < 4; ++m) _Pragma("unroll") for (int k = 0; k < 2; ++k) dst[m][k] = *(const LAS bf16x8*)(lds + PG8_SA(b, h) + aoff + m * 2048 + k * 1024); } while (0)
#define PG8_LDB(dst, b, h) do { _Pragma("unroll") for (int n = 0; n < 2; ++n) _Pragma("unroll") for (int k = 0; k < 2; ++k) dst[n][k] = *(const LAS bf16x8*)(lds + PG8_SB(b, h) + boff + n * 2048 + k * 1024); } while (0)
#define PG8_MMA(ai, bj, At, Bt) do { __builtin_amdgcn_s_setprio(1); _Pragma("unroll") for (int m = 0; m < 4; ++m) _Pragma("unroll") for (int n = 0; n < 2; ++n) _Pragma("unroll") for (int k = 0; k < 2; ++k) \
        acc[ai][bj][m][n] = __builtin_amdgcn_mfma_f32_16x16x32_bf16(Bt[n][k], At[m][k], acc[ai][bj][m][n], 0, 0, 0); __builtin_amdgcn_s_setprio(0); } while (0)
#define PG8_WAIT_V(n) asm volatile("s_waitcnt vmcnt(" #n ")" ::: "memory")
#define PG8_WAIT_L(n) asm volatile("s_waitcnt lgkmcnt(" #n ")" ::: "memory")
#define PG8_BAR __builtin_amdgcn_s_barrier()
#define PG8_SCHED __builtin_amdgcn_sched_barrier(0)
    Unit cur, nxt; int ui = 0;
    if (!S.next(0, cur)) return;
    f32x4 acc[2][2][4][2];
#pragma unroll
    for (int a = 0; a < 2; ++a)
#pragma unroll
        for (int b = 0; b < 2; ++b)
#pragma unroll
            for (int m = 0; m < 4; ++m)
#pragma unroll
                for (int n = 0; n < 2; ++n) acc[a][b][m][n] = (f32x4){0.f, 0.f, 0.f, 0.f};
    bf16x8 At[4][2], B0[2][2], B1[2][2];
    const char* cA = (const char*)g.A + (size_t)cur.pm * tstep + (size_t)cur.k0 * kstep; const char* cB = (const char*)g.Bt + (size_t)cur.pn * tstep + (size_t)cur.k0 * kstep;
    if constexpr (SP2) {
        PG8_STAGE(PG8_SB(0, 0), cB, voffB); PG8_STAGE(PG8_SB(0, 1), cB + hstep, voffB); PG8_STAGE(PG8_SA(0, 0), cA, voffA); PG8_STAGE(PG8_SA(0, 1), cA + hstep, voffA);
        if (wr == 1) PG8_BAR;
        PG8_WAIT_V(2); PG8_BAR;
        PG8_STAGE(PG8_SB(1, 0), cB + kstep, voffB); PG8_STAGE(PG8_SA(1, 0), cA + kstep, voffA); PG8_STAGE(PG8_SB(1, 1), cB + hstep + kstep, voffB);
        PG8_WAIT_V(6); PG8_BAR;
    } else {
        PG8_STAGE(PG8_SB(0, 0), cB, voffB); PG8_STAGE(PG8_SA(0, 0), cA, voffA); PG8_STAGE(PG8_SB(0, 1), cB + hstep, voffB); PG8_STAGE(PG8_SA(0, 1), cA + hstep, voffA);
        if (wr == 1) PG8_BAR;
        PG8_WAIT_V(4); PG8_BAR;
        PG8_STAGE(PG8_SB(1, 0), cB + kstep, voffB); PG8_STAGE(PG8_SA(1, 0), cA + kstep, voffA); PG8_STAGE(PG8_SB(1, 1), cB + hstep + kstep, voffB);
        PG8_WAIT_V(6); PG8_BAR;
    }
    for (;;) {
        const bool has_next = S.next(ui + 1, nxt);
        const char* nA = has_next ? (const char*)g.A + (size_t)nxt.pm * tstep + (size_t)nxt.k0 * kstep : cA; const char* nB = has_next ? (const char*)g.Bt + (size_t)nxt.pn * tstep + (size_t)nxt.k0 * kstep : cB;
        const int nt = cur.nt;
        for (int t = 0; t < nt; t += 2) {
            const bool last = (t == nt - 2);
            const char* a1 = cA + (size_t)(t + 1) * kstep;
            const char* a2 = last ? nA : cA + (size_t)(t + 2) * kstep; const char* b2 = last ? nB : cB + (size_t)(t + 2) * kstep;
            const char* a3 = a2 + kstep; const char* b3 = b2 + kstep;
            if constexpr (SP2) {
            PG8_LDB(B0, 0, 0); PG8_LDB(B1, 0, 1); PG8_SCHED; PG8_LDA(At, 0, 0); PG8_STAGE(PG8_SA(1, 1), a1 + hstep, voffA);
            PG8_WAIT_V(8); PG8_WAIT_L(0); PG8_BAR; PG8_MMA(0, 0, At, B0); PG8_MMA(0, 1, At, B1); PG8_BAR; PG8_SCHED;
            PG8_LDA(At, 0, 1); PG8_STAGE(PG8_SB(0, 0), b2, voffB); PG8_STAGE(PG8_SB(0, 1), b2 + hstep, voffB); PG8_STAGE(PG8_SA(0, 0), a2, voffA);
            PG8_WAIT_V(8); PG8_WAIT_L(0); PG8_BAR; PG8_MMA(1, 0, At, B0); PG8_MMA(1, 1, At, B1); PG8_BAR; PG8_SCHED;
            PG8_LDB(B0, 1, 0); PG8_LDB(B1, 1, 1); PG8_SCHED; PG8_LDA(At, 1, 0); PG8_STAGE(PG8_SA(0, 1), a2 + hstep, voffA);
            PG8_WAIT_V(8); PG8_WAIT_L(0); PG8_BAR; PG8_MMA(0, 0, At, B0); PG8_MMA(0, 1, At, B1); PG8_BAR; PG8_SCHED;
            PG8_LDA(At, 1, 1); PG8_STAGE(PG8_SB(1, 0), b3, voffB); PG8_STAGE(PG8_SB(1, 1), b3 + hstep, voffB); PG8_STAGE(PG8_SA(1, 0), a3, voffA);
            PG8_WAIT_V(8); PG8_WAIT_L(0); PG8_BAR; PG8_MMA(1, 0, At, B0); PG8_MMA(1, 1, At, B1); PG8_BAR; PG8_SCHED;
            } else {
            PG8_LDB(B0, 0, 0); PG8_SCHED; PG8_LDA(At, 0, 0); PG8_STAGE(PG8_SA(1, 1), a1 + hstep, voffA);
            PG8_WAIT_L(8); PG8_BAR; PG8_WAIT_L(0); PG8_MMA(0, 0, At, B0); PG8_BAR; PG8_SCHED;
            PG8_LDB(B1, 0, 1); PG8_STAGE(PG8_SB(0, 0), b2, voffB);
            PG8_BAR; PG8_WAIT_L(0); PG8_MMA(0, 1, At, B1); PG8_BAR;
            PG8_LDA(At, 0, 1); PG8_STAGE(PG8_SA(0, 0), a2, voffA);
            PG8_BAR; PG8_WAIT_L(0); PG8_MMA(1, 0, At, B0); PG8_BAR; PG8_SCHED;
            PG8_STAGE(PG8_SB(0, 1), b2 + hstep, voffB);
            PG8_WAIT_V(6); PG8_BAR; PG8_MMA(1, 1, At, B1); PG8_BAR;
            PG8_LDB(B0, 1, 0); PG8_SCHED; PG8_LDA(At, 1, 0); PG8_STAGE(PG8_SA(0, 1), a2 + hstep, voffA);
            PG8_WAIT_L(8); PG8_BAR; PG8_WAIT_L(0); PG8_MMA(0, 0, At, B0); PG8_BAR; PG8_SCHED;
            PG8_LDB(B1, 1, 1); PG8_STAGE(PG8_SB(1, 0), b3, voffB);
            PG8_BAR; PG8_WAIT_L(0); PG8_MMA(0, 1, At, B1); PG8_BAR;
            PG8_LDA(At, 1, 1); PG8_STAGE(PG8_SA(1, 0), a3, voffA);
            PG8_BAR; PG8_WAIT_L(0); PG8_MMA(1, 0, At, B0); PG8_BAR; PG8_SCHED;
            PG8_STAGE(PG8_SB(1, 1), b3 + hstep, voffB);
            PG8_WAIT_V(6); PG8_BAR; PG8_MMA(1, 1, At, B1); PG8_BAR;
            }
        }
        if constexpr (ALIGN_EPI) { if (wr == 0) PG8_BAR; }
        if (cur.split < 0) E(acc, cur, wr, wc, fr, fq);
        else {
            float* slab = sc.part + (size_t)cur.split * (128 * g.N) + cur.pn * 256;
#pragma unroll
            for (int m = 0; m < 4; ++m)
#pragma unroll
                for (int bj = 0; bj < 2; ++bj)
#pragma unroll
                    for (int n = 0; n < 2; ++n) *(f32x4*)(slab + (size_t)(wr * 64 + m * 16 + fr) * g.N + bj * 128 + wc * 32 + (Epi::PERM ? 8 * fq + 4 * n : n * 16 + 4 * fq)) = acc[0][bj][m][n];
            asm volatile("s_waitcnt vmcnt(0) lgkmcnt(0)" ::: "memory"); __builtin_amdgcn_s_barrier(); asm volatile("" ::: "memory");
            if (tid == 0) {
                __builtin_amdgcn_fence(__ATOMIC_RELEASE, "agent");
                asm volatile("s_waitcnt vmcnt(0)" ::: "memory");
                __hip_atomic_fetch_add(sc.cnt, 1u, __ATOMIC_RELAXED, __HIP_MEMORY_SCOPE_AGENT);
            }
        }
        if (!has_next) break;
#pragma unroll
        for (int a = 0; a < 2; ++a)
#pragma unroll
            for (int b = 0; b < 2; ++b)
#pragma unroll
                for (int m = 0; m < 4; ++m)
#pragma unroll
                    for (int n = 0; n < 2; ++n) acc[a][b][m][n] = (f32x4){0.f, 0.f, 0.f, 0.f};
        cur = nxt; cA = nA; cB = nB; ++ui;
        if constexpr (ALIGN_EPI) { if (wr == 1) PG8_BAR; }
    }
    PG8_WAIT_V(0);
    if constexpr (!ALIGN_EPI) { if (wr == 0) PG8_BAR; }
    PG8_BAR;
#undef PG8_SA
#undef PG8_SB
#undef PG8_STAGE
#undef PG8_LDA
#undef PG8_LDB
#undef PG8_MMA
#undef PG8_WAIT_V
#undef PG8_WAIT_L
#undef PG8_BAR
#undef PG8_SCHED
}
}

struct EpiGateUp {
    static constexpr bool PERM = true;
    bf16_t* act; const float* ss;
    __device__ __forceinline__ void operator()(const f32x4 (&acc)[2][2][4][2], const pg8::Unit& u, int wr, int wc, int fr, int fq) const {
        float ssv[2][4];
#pragma unroll
        for (int ai = 0; ai < 2; ++ai)
#pragma unroll
            for (int m = 0; m < 4; ++m) ssv[ai][m] = ss[u.pm * 256 + ai * 128 + wr * 64 + m * 16 + fr];
#pragma unroll
        for (int ai = 0; ai < 2; ++ai)
#pragma unroll
            for (int m = 0; m < 4; ++m) {
                const int row = u.pm * 256 + ai * 128 + wr * 64 + m * 16 + fr;
                const float rs = __builtin_amdgcn_rsqf(ssv[ai][m] * (1.0f / DM) + EPS);
                float v[8];
#pragma unroll
                for (int n = 0; n < 2; ++n)
#pragma unroll
                    for (int i = 0; i < 4; ++i) { const float gt = acc[ai][0][m][n][i] * rs, up = acc[ai][1][m][n][i] * rs; v[n * 4 + i] = gt * sigmoidf_(gt) * up; }
                u32x4 w; w.x = pk2(v[0], v[1]); w.y = pk2(v[2], v[3]); w.z = pk2(v[4], v[5]); w.w = pk2(v[6], v[7]);
                *(u32x4*)(act + (size_t)row * DFF + u.pn * 128 + wc * 32 + 8 * fq) = w;
            }
    }
};
template <bool BASE_X> struct EpiResid {
    static constexpr bool PERM = true;
    const float* xp; const float* xs; bf16_t* hb; float* ssn; float scale;
    __device__ __forceinline__ void operator()(const f32x4 (&acc)[2][2][4][2], const pg8::Unit& u, int wr, int wc, int fr, int fq) const {
#pragma unroll
        for (int ai = 0; ai < 2; ++ai) {
            u32x2 hw[4][2][2];
#pragma unroll
            for (int m = 0; m < 4; ++m) {
                const int row = u.pm * 256 + ai * 128 + wr * 64 + m * 16 + fr;
#pragma unroll
                for (int bj = 0; bj < 2; ++bj)
#pragma unroll
                    for (int n = 0; n < 2; ++n) hw[m][bj][n] = *(const u32x2*)(hb + (size_t)row * DM + u.pn * 256 + bj * 128 + wc * 32 + 8 * fq + 4 * n);
            }
#pragma unroll
            for (int m = 0; m < 4; ++m) {
                const int row = u.pm * 256 + ai * 128 + wr * 64 + m * 16 + fr;
                float sq = 0.f;
#pragma unroll
                for (int bj = 0; bj < 2; ++bj)
#pragma unroll
                    for (int n = 0; n < 2; ++n) {
                        const int col = u.pn * 256 + bj * 128 + wc * 32 + 8 * fq + 4 * n;
                        const u32x2 h2 = hw[m][bj][n];
                        const f32x4 hv = (f32x4){bflo(h2.x), bfhi(h2.x), bflo(h2.y), bfhi(h2.y)} + acc[ai][bj][m][n] * scale;
                        u32x2 w; w.x = pk2(hv[0], hv[1]); w.y = pk2(hv[2], hv[3]);
                        *(u32x2*)(hb + (size_t)row * DM + col) = w;
                        sq += (hv[0] * hv[0] + hv[1] * hv[1]) + (hv[2] * hv[2] + hv[3] * hv[3]);
                    }
                sq += __shfl_xor(sq, 16); sq += __shfl_xor(sq, 32);
                if (fq == 0) atomicAdd(ssn + row, sq);
            }
        }
    }
};
struct EpiFinal {
    static constexpr bool PERM = true;
    float* out; const bf16_t* hb; float* ssn; unsigned* pcnt; const float* gamma; float scale;
    __device__ __forceinline__ void operator()(f32x4 (&acc)[2][2][4][2], const pg8::Unit& u, int wr, int wc, int fr, int fq) const {
#pragma unroll
        for (int ai = 0; ai < 2; ++ai) {
            u32x2 hwv[4][2][2];
#pragma unroll
            for (int m = 0; m < 4; ++m) {
                const int row = u.pm * 256 + ai * 128 + wr * 64 + m * 16 + fr;
#pragma unroll
                for (int bj = 0; bj < 2; ++bj)
#pragma unroll
                    for (int n = 0; n < 2; ++n) hwv[m][bj][n] = *(const u32x2*)(hb + (size_t)row * DM + u.pn * 256 + bj * 128 + wc * 32 + 8 * fq + 4 * n);
            }
#pragma unroll
            for (int m = 0; m < 4; ++m) {
                const int row = u.pm * 256 + ai * 128 + wr * 64 + m * 16 + fr;
                float sq = 0.f;
#pragma unroll
                for (int bj = 0; bj < 2; ++bj)
#pragma unroll
                    for (int n = 0; n < 2; ++n) {
                        const u32x2 hw = hwv[m][bj][n];
                        const f32x4 hv = (f32x4){bflo(hw.x), bfhi(hw.x), bflo(hw.y), bfhi(hw.y)} + acc[ai][bj][m][n] * scale;
                        acc[ai][bj][m][n] = hv;
                        sq += (hv[0] * hv[0] + hv[1] * hv[1]) + (hv[2] * hv[2] + hv[3] * hv[3]);
                    }
                sq += __shfl_xor(sq, 16); sq += __shfl_xor(sq, 32);
                if (fq == 0) atomicAdd(ssn + row, sq);
            }
        }
        asm volatile("s_waitcnt vmcnt(0) lgkmcnt(0)" ::: "memory"); __builtin_amdgcn_s_barrier(); asm volatile("" ::: "memory");
        if (wr == 0 && wc == 0 && fr == 0 && fq == 0) {
            __builtin_amdgcn_fence(__ATOMIC_RELEASE, "agent");
            asm volatile("s_waitcnt vmcnt(0)" ::: "memory");
            __hip_atomic_fetch_add(pcnt + u.pm, 1u, __ATOMIC_RELAXED, __HIP_MEMORY_SCOPE_AGENT);
            unsigned sp = 0;
            while (__hip_atomic_load(pcnt + u.pm, __ATOMIC_RELAXED, __HIP_MEMORY_SCOPE_AGENT) < 4u) { __builtin_amdgcn_s_sleep(1); if (++sp > (1u << 22)) break; }
            __builtin_amdgcn_fence(__ATOMIC_ACQUIRE, "agent");
            asm volatile("s_waitcnt vmcnt(0)" ::: "memory");
        }
        asm volatile("s_waitcnt vmcnt(0) lgkmcnt(0)" ::: "memory"); __builtin_amdgcn_s_barrier(); asm volatile("" ::: "memory");
        float sv[2][4]; f32x4 gnv[2][2];
#pragma unroll
        for (int ai = 0; ai < 2; ++ai)
#pragma unroll
            for (int m = 0; m < 4; ++m) sv[ai][m] = __hip_atomic_load(ssn + u.pm * 256 + ai * 128 + wr * 64 + m * 16 + fr, __ATOMIC_RELAXED, __HIP_MEMORY_SCOPE_AGENT);
#pragma unroll
        for (int bj = 0; bj < 2; ++bj)
#pragma unroll
            for (int n = 0; n < 2; ++n) gnv[bj][n] = *(const f32x4*)(gamma + u.pn * 256 + bj * 128 + wc * 32 + 8 * fq + 4 * n);
#pragma unroll
        for (int ai = 0; ai < 2; ++ai)
#pragma unroll
            for (int m = 0; m < 4; ++m) {
                const int row = u.pm * 256 + ai * 128 + wr * 64 + m * 16 + fr;
                const float rs = __builtin_amdgcn_rsqf(sv[ai][m] * (1.0f / DM) + EPS);
#pragma unroll
                for (int bj = 0; bj < 2; ++bj)
#pragma unroll
                    for (int n = 0; n < 2; ++n) {
                        const int col = u.pn * 256 + bj * 128 + wc * 32 + 8 * fq + 4 * n;
                        *(f32x4*)(out + (size_t)row * DM + col) = acc[ai][bj][m][n] * rs * gnv[bj][n];
                    }
            }
    }
};
struct EpiInProj {
    static constexpr bool PERM = true;
    bf16_t* p; const float* ss;
    __device__ __forceinline__ void operator()(const f32x4 (&acc)[2][2][4][2], const pg8::Unit& u, int wr, int wc, int fr, int fq) const {
        float ssv[2][4];
#pragma unroll
        for (int ai = 0; ai < 2; ++ai)
#pragma unroll
            for (int m = 0; m < 4; ++m) ssv[ai][m] = ss[u.pm * 256 + ai * 128 + wr * 64 + m * 16 + fr];
#pragma unroll
        for (int ai = 0; ai < 2; ++ai)
#pragma unroll
            for (int m = 0; m < 4; ++m) {
                const int row = u.pm * 256 + ai * 128 + wr * 64 + m * 16 + fr;
                const float rs = __builtin_amdgcn_rsqf(ssv[ai][m] * (1.0f / DM) + EPS);
#pragma unroll
                for (int bj = 0; bj < 2; ++bj) {
                    const f32x4 a = acc[ai][bj][m][0] * rs, b = acc[ai][bj][m][1] * rs;
                    u32x4 w; w.x = pk2(a[0], a[1]); w.y = pk2(a[2], a[3]); w.z = pk2(b[0], b[1]); w.w = pk2(b[2], b[3]);
                    *(u32x4*)(p + (size_t)row * PW + u.pn * 256 + bj * 128 + wc * 32 + 8 * fq) = w;
                }
            }
    }
};
struct EpiGlu {
    static constexpr bool PERM = true;
    const bf16_t* z; const float* bias; bf16_t* mix;
    __device__ __forceinline__ void operator()(const f32x4 (&acc)[2][2][4][2], const pg8::Unit& u, int wr, int wc, int fr, int fq) const {
#pragma unroll
        for (int bj = 0; bj < 2; ++bj) {
            const int col = u.pn * 256 + bj * 128 + wc * 32 + 8 * fq;
            const f32x4 b0 = *(const f32x4*)(bias + col), b1 = *(const f32x4*)(bias + col + 4);
            u32x4 zv[2][4];
#pragma unroll
            for (int ai = 0; ai < 2; ++ai)
#pragma unroll
                for (int m = 0; m < 4; ++m) zv[ai][m] = *(const u32x4*)(z + (size_t)(u.pm * 256 + ai * 128 + wr * 64 + m * 16 + fr) * SSMW + col);
#pragma unroll
            for (int ai = 0; ai < 2; ++ai)
#pragma unroll
                for (int m = 0; m < 4; ++m) {
                    const int row = u.pm * 256 + ai * 128 + wr * 64 + m * 16 + fr;
                    const u32x4 zz = zv[ai][m];
                    const f32x4 a = acc[ai][bj][m][0] + b0, b = acc[ai][bj][m][1] + b1;
                    u32x4 w;
                    w.x = pk2(bflo(zz.x) * sigmoidf_(a[0]), bfhi(zz.x) * sigmoidf_(a[1]));
                    w.y = pk2(bflo(zz.y) * sigmoidf_(a[2]), bfhi(zz.y) * sigmoidf_(a[3]));
                    w.z = pk2(bflo(zz.z) * sigmoidf_(b[0]), bfhi(zz.z) * sigmoidf_(b[1]));
                    w.w = pk2(bflo(zz.w) * sigmoidf_(b[2]), bfhi(zz.w) * sigmoidf_(b[3]));
                    *(u32x4*)(mix + (size_t)row * DM + col) = w;
                }
        }
    }
};

template <bool BASE_X, bool WRITE_HB, int NKS>
__device__ __forceinline__ void sample_finalize(const float* part, unsigned* cnt, int nks, int nsplit_units, const float* xs, float* out, bf16_t* hb, float* ssn, float scale,
                                                int bid, int wave, int lane, int tid, LAS unsigned char* lds) {
    if (bid >= 128) return;
    if (tid == 0) {
        unsigned sp = 0;
        while (__hip_atomic_load(cnt, __ATOMIC_RELAXED, __HIP_MEMORY_SCOPE_AGENT) < (unsigned)nsplit_units) { __builtin_amdgcn_s_sleep(2); if (++sp > (1u << 22)) break; }
        __builtin_amdgcn_fence(__ATOMIC_ACQUIRE, "agent");
        asm volatile("s_waitcnt vmcnt(0)" ::: "memory");
    }
    __syncthreads();
    if (wave < 4) {
        const int r = bid, col = wave * 256 + lane * 4, row = NPROMPT + r;
        f32x4 pv[NKS];
#pragma unroll
        for (int ks = 0; ks < NKS; ++ks) pv[ks] = *(const f32x4*)(part + ((size_t)ks * 128 + r) * DM + col);
        f32x4 s = (f32x4){0.f, 0.f, 0.f, 0.f};
#pragma unroll
        for (int ks = 0; ks < NKS; ++ks) s += pv[ks];
        f32x4 hv; { const u32x2 hw = *(const u32x2*)(hb + (size_t)row * DM + col); hv = (f32x4){bflo(hw.x), bfhi(hw.x), bflo(hw.y), bfhi(hw.y)} + s * scale; }
        if (WRITE_HB) { u32x2 w; w.x = pk2(hv[0], hv[1]); w.y = pk2(hv[2], hv[3]); *(u32x2*)(hb + (size_t)row * DM + col) = w; }
        float sq = (hv[0] * hv[0] + hv[1] * hv[1]) + (hv[2] * hv[2] + hv[3] * hv[3]);
        sq = wave_sum(sq);
        if (lane == 0) atomicAdd(ssn + row, sq);
    }
}

template <int NKS>
__device__ __forceinline__ void sample_finalize_norm(const float* part, unsigned* cnt, int nks, int nsplit_units, float* out, const bf16_t* hb, const float* gamma, float scale,
                                                     int bid, int wave, int lane, int tid, LAS unsigned char* lds) {
    if (bid >= 128) return;
    if (tid == 0) {
        unsigned sp = 0;
        while (__hip_atomic_load(cnt, __ATOMIC_RELAXED, __HIP_MEMORY_SCOPE_AGENT) < (unsigned)nsplit_units) { __builtin_amdgcn_s_sleep(2); if (++sp > (1u << 22)) break; }
        __builtin_amdgcn_fence(__ATOMIC_ACQUIRE, "agent");
        asm volatile("s_waitcnt vmcnt(0)" ::: "memory");
    }
    __syncthreads();
    LAS float* red = (LAS float*)(lds + 131072 + 1024);
    const int r = bid, col = (wave & 3) * 256 + lane * 4, row = NPROMPT + r;
    f32x4 hv = (f32x4){0.f, 0.f, 0.f, 0.f};
    if (wave < 4) {
        f32x4 pv[NKS];
#pragma unroll
        for (int ks = 0; ks < NKS; ++ks) pv[ks] = *(const f32x4*)(part + ((size_t)ks * 128 + r) * DM + col);
        f32x4 s = (f32x4){0.f, 0.f, 0.f, 0.f};
#pragma unroll
        for (int ks = 0; ks < NKS; ++ks) s += pv[ks];
        { const u32x2 hw = *(const u32x2*)(hb + (size_t)row * DM + col); hv = (f32x4){bflo(hw.x), bfhi(hw.x), bflo(hw.y), bfhi(hw.y)} + s * scale; }
        float sq = (hv[0] * hv[0] + hv[1] * hv[1]) + (hv[2] * hv[2] + hv[3] * hv[3]);
        sq = wave_sum(sq);
        if (lane == 0) red[wave] = sq;
    }
    __syncthreads();
    if (wave < 4) {
        const float tot = (red[0] + red[1]) + (red[2] + red[3]);
        const float rs = __builtin_amdgcn_rsqf(tot * (1.0f / DM) + EPS);
        const f32x4 gn = *(const f32x4*)(gamma + col);
        *(f32x4*)(out + (size_t)row * DM + col) = hv * rs * gn;
    }
}

__device__ __forceinline__ void transpose_item(const float* W, int N, int k0, int n0, bf16_t* WT, int K, int drow0, const float* gain, LAS float* scr, int lane) {
    float wv[32];
    const float* wp = W + (size_t)(k0 + (lane >> 5)) * N + n0 + (lane & 31);
#pragma unroll
    for (int i = 0; i < 32; ++i) wv[i] = wp[(size_t)(2 * i) * N];
    const float gsc = gain ? gain[k0 + lane] : 1.0f;
#pragma unroll
    for (int i = 0; i < 32; ++i) { const int kk = 2 * i + (lane >> 5); scr[kk * 33 + (lane & 31)] = wv[i] * __shfl(gsc, kk); }
    LDS_WAIT();
    const int c = lane & 7;
#pragma unroll
    for (int j = 0; j < 4; ++j) { const int n = (lane >> 3) + 8 * j; const LAS float* s = scr + (8 * c) * 33 + n;
        u32x4 o; o.x = pk2(s[0 * 33], s[1 * 33]); o.y = pk2(s[2 * 33], s[3 * 33]); o.z = pk2(s[4 * 33], s[5 * 33]); o.w = pk2(s[6 * 33], s[7 * 33]);
        *(u32x4*)(WT + (size_t)(drow0 + n) * K + k0 + 8 * c) = o; }
    LDS_WAIT();
}
template <int GU>
__device__ __forceinline__ void transpose_matrix(const float* W, int K, int N, bf16_t* WT, const float* gain, LAS float* scr, int lane, int gw, int NGW) {
    const int nblk = N / 32, nitems = (K / 64) * nblk;
    for (int it = gw; it < nitems; it += NGW) {
        const int kb = it / nblk, nb = it % nblk, n0 = nb * 32;
        const int drow0 = GU == 0 ? n0 : (256 * (n0 / 128) + (n0 % 128) + (GU == 2 ? 128 : 0));
        transpose_item(W, N, kb * 64, n0, WT, K, drow0, gain, scr, lane);
    }
}

__device__ __forceinline__ int tau32(int r) { return (r & 3) + 4 * (r >> 3) + 16 * ((r >> 2) & 1); }
constexpr int XS_STRIDE = 272, XS_BYTES = 32 * XS_STRIDE;

template <int MODE>
__device__ __forceinline__ void ssm_item(const Params& P, LAS unsigned char* xs, int lane, int item) {
    unsigned char* ws = P.ws;
    const bf16_t* pb = (const bf16_t*)(ws + WS_P);
    bf16_t* zb = (bf16_t*)(ws + WS_Z);
    const float2* tab_ab = (const float2*)(ws + WS_TAB + T_AB);
    const float2* tab_ab16 = (const float2*)(ws + WS_TAB + T_AB16);
    const float2* tab_ab128 = (const float2*)(ws + WS_TAB + T_AB128);
    float2* Eb = (float2*)(ws + WS_E);
    const int c = lane & 31, h = lane >> 5;
    int g, b = 0, ch = 0, row0, nblk;
    if (MODE == 2) { g = item & 31; const int sb = item >> 5; row0 = NPROMPT + sb * 32; nblk = 1; b = sb * 32; }
    else { g = item & 31; ch = (item >> 5) % NCH; b = item / (32 * NCH); row0 = b * SEQ + ch * TCH; nblk = TCH / 32; }
    const float2 a0 = tab_ab[g * 64 + c], a1 = tab_ab[g * 64 + c + 32];
    bf16x8 bfr[4];
#pragma unroll
    for (int nt = 0; nt < 4; ++nt) bfr[nt] = *(const bf16x8*)(ws + WS_TAB + T_BF + ((size_t)(g * 4 + nt) * 64 + lane) * 16);
    bf16x8 cfr[4];
    f32x4 dsk4 = (f32x4){0.f, 0.f, 0.f, 0.f};
    if (MODE != 0) {
#pragma unroll
        for (int kk = 0; kk < 4; ++kk) cfr[kk] = *(const bf16x8*)(ws + WS_TAB + T_CF + ((size_t)(g * 4 + kk) * 64 + lane) * 16);
        dsk4 = *(const f32x4*)(P.in[18] + g * 16 + 4 * (lane >> 4));
    }
    float X0r = 0.f, X0i = 0.f, X1r = 0.f, X1i = 0.f;
    if (MODE == 1) {
        const float2 p0 = tab_ab128[g * 64 + c], p1 = tab_ab128[g * 64 + c + 32];
        const float2* e0p = Eb + ((size_t)(b * NCH) * 32 + g) * 64 + c;
        for (int cc0 = 0; cc0 < ch; cc0 += 4) {
            float2 e0[4], e1[4];
#pragma unroll
            for (int q = 0; q < 4; ++q) { const int cc = (cc0 + q < ch) ? cc0 + q : ch - 1; e0[q] = e0p[(size_t)cc * 2048]; e1[q] = e0p[(size_t)cc * 2048 + 32]; }
#pragma unroll
            for (int q = 0; q < 4; ++q) if (cc0 + q < ch) {
                const float t0r = p0.x * X0r - p0.y * X0i + e0[q].x, t0i = p0.x * X0i + p0.y * X0r + e0[q].y; X0r = t0r; X0i = t0i;
                const float t1r = p1.x * X1r - p1.y * X1i + e1[q].x, t1i = p1.x * X1i + p1.y * X1r + e1[q].y; X1r = t1r; X1i = t1i;
            }
        }
    }
    const int tok = tau32(c);
    constexpr int NBLK = (MODE == 2) ? 1 : TCH / 32;
    bf16x8 afr[NBLK];
#pragma unroll
    for (int blk = 0; blk < NBLK; ++blk) afr[blk] = *(const bf16x8*)(pb + (size_t)(row0 + blk * 32 + tok) * PW + g * 16 + 8 * h);
#pragma unroll
    for (int blk = 0; blk < NBLK; ++blk) {
        const int rb = row0 + blk * 32;
        const bf16x8 af = afr[blk];
        u32x2 uraw[2];
        if (MODE != 0) {
#pragma unroll
            for (int tb = 0; tb < 2; ++tb) uraw[tb] = *(const u32x2*)(pb + (size_t)(rb + tb * 16 + (lane & 15)) * PW + g * 16 + 4 * (lane >> 4));
        }
        f32x16 D0, D1, D2, D3;
        {
            f32x16 zz;
#pragma unroll
            for (int i = 0; i < 16; ++i) zz[i] = 0.f;
            D0 = __builtin_amdgcn_mfma_f32_32x32x16_bf16(af, bfr[0], zz, 0, 0, 0);
            D1 = __builtin_amdgcn_mfma_f32_32x32x16_bf16(af, bfr[1], zz, 0, 0, 0);
            D2 = __builtin_amdgcn_mfma_f32_32x32x16_bf16(af, bfr[2], zz, 0, 0, 0);
            D3 = __builtin_amdgcn_mfma_f32_32x32x16_bf16(af, bfr[3], zz, 0, 0, 0);
        }
        if (MODE == 2) {
            const float* sre = P.in[2]; const float* sim = P.in[3];
            float* ore = P.out + O_RES; float* oim = P.out + O_IMS;
            float h0r[16], h0i[16], h1r[16], h1i[16];
#pragma unroll
            for (int s = 0; s < 16; ++s) {
                const size_t o = ((size_t)(b + s + 16 * h) * 32 + g) * 64 + c;
                h0r[s] = sre[o]; h0i[s] = sim[o]; h1r[s] = sre[o + 32]; h1i[s] = sim[o + 32];
            }
#pragma unroll
            for (int s = 0; s < 16; ++s) {
                const size_t o = ((size_t)(b + s + 16 * h) * 32 + g) * 64 + c;
                D0[s] += a0.x * h0r[s] - a0.y * h0i[s]; D2[s] += a0.x * h0i[s] + a0.y * h0r[s];
                D1[s] += a1.x * h1r[s] - a1.y * h1i[s]; D3[s] += a1.x * h1i[s] + a1.y * h1r[s];
                ore[o] = D0[s]; oim[o] = D2[s]; ore[o + 32] = D1[s]; oim[o + 32] = D3[s];
            }
        } else {
            float x0r = h ? 0.f : X0r, x0i = h ? 0.f : X0i, x1r = h ? 0.f : X1r, x1i = h ? 0.f : X1i;
#pragma unroll
            for (int s = 0; s < 16; ++s) {
                const float n0r = a0.x * x0r - a0.y * x0i + D0[s], n0i = a0.x * x0i + a0.y * x0r + D2[s];
                const float n1r = a1.x * x1r - a1.y * x1i + D1[s], n1i = a1.x * x1i + a1.y * x1r + D3[s];
                x0r = n0r; x0i = n0i; x1r = n1r; x1i = n1i;
                D0[s] = x0r; D2[s] = x0i; D1[s] = x1r; D3[s] = x1i;
            }
            const float y0r = __shfl(x0r, c), y0i = __shfl(x0i, c), y1r = __shfl(x1r, c), y1i = __shfl(x1i, c);
            if (MODE == 0) {
                const float2 q0 = tab_ab16[g * 64 + c], q1 = tab_ab16[g * 64 + c + 32];
                const float e0r = x0r + q0.x * y0r - q0.y * y0i, e0i = x0i + q0.x * y0i + q0.y * y0r;
                const float e1r = x1r + q1.x * y1r - q1.y * y1i, e1i = x1i + q1.x * y1i + q1.y * y1r;
                X0r = __shfl(e0r, c + 32); X0i = __shfl(e0i, c + 32); X1r = __shfl(e1r, c + 32); X1i = __shfl(e1i, c + 32);
            } else {
                float c0r = h ? y0r : 0.f, c0i = h ? y0i : 0.f, c1r = h ? y1r : 0.f, c1i = h ? y1i : 0.f;
#pragma unroll
                for (int s = 0; s < 16; ++s) {
                    const float n0r = a0.x * c0r - a0.y * c0i, n0i = a0.x * c0i + a0.y * c0r;
                    const float n1r = a1.x * c1r - a1.y * c1i, n1i = a1.x * c1i + a1.y * c1r;
                    c0r = n0r; c0i = n0i; c1r = n1r; c1i = n1i;
                    D0[s] += c0r; D2[s] += c0i; D1[s] += c1r; D3[s] += c1i;
                }
                X0r = __shfl(D0[15], c + 32); X0i = __shfl(D2[15], c + 32); X1r = __shfl(D1[15], c + 32); X1i = __shfl(D3[15], c + 32);
            }
        }
        if (MODE != 0) {
#pragma unroll
            for (int s = 0; s < 16; ++s) {
                u32x2 w; w.x = cvt_pk_bf16(D0[s], D2[s]); w.y = cvt_pk_bf16(D1[s], D3[s]);
                *(LAS u32x2*)(xs + (s + 16 * h) * XS_STRIDE + c * 8) = w;
            }
            LDS_WAIT();
            const int chn = lane & 15, q = lane >> 4;
#pragma unroll
            for (int tb = 0; tb < 2; ++tb) {
                f32x4 y = (f32x4){0.f, 0.f, 0.f, 0.f};
#pragma unroll
                for (int kk = 0; kk < 4; ++kk) {
                    const bf16x8 xa = *(const LAS bf16x8*)(xs + (tb * 16 + chn) * XS_STRIDE + kk * 64 + q * 16);
                    y = __builtin_amdgcn_mfma_f32_16x16x32_bf16(cfr[kk], xa, y, 0, 0, 0);
                }
                {
                    const int row = rb + tb * 16 + chn;
                    const u32x2 uu = uraw[tb];
                    const float z0 = gelu_tanh(y[0] + dsk4[0] * bflo(uu.x)), z1 = gelu_tanh(y[1] + dsk4[1] * bfhi(uu.x));
                    const float z2 = gelu_tanh(y[2] + dsk4[2] * bflo(uu.y)), z3 = gelu_tanh(y[3] + dsk4[3] * bfhi(uu.y));
                    u32x2 w; w.x = cvt_pk_bf16(z0, z1); w.y = cvt_pk_bf16(z2, z3);
                    *(u32x2*)(zb + (size_t)row * SSMW + g * 16 + 4 * q) = w;
                }
            }
            LDS_WAIT();
        }
    }
    if (MODE == 0) {
        if (h == 0) { Eb[((size_t)(b * NCH + ch) * 32 + g) * 64 + c] = make_float2(X0r, X0i); Eb[((size_t)(b * NCH + ch) * 32 + g) * 64 + c + 32] = make_float2(X1r, X1i); }
    }
    if (MODE == 1) {
        if (ch == NCH - 1 && h == 0) {
            float* ore = P.out + O_REP; float* oim = P.out + O_IMP; const size_t o = ((size_t)b * 32 + g) * 64 + c;
            ore[o] = X0r; oim[o] = X0i; ore[o + 32] = X1r; oim[o + 32] = X1i;
        }
    }
}

template <int MODE>
__device__ __forceinline__ void ssm_pair_item(const Params& P, LAS unsigned char* xs, int lane, int item) {
    unsigned char* ws = P.ws;
    const bf16_t* pb = (const bf16_t*)(ws + WS_P);
    bf16_t* zb = (bf16_t*)(ws + WS_Z);
    const float2* tab_ab = (const float2*)(ws + WS_TAB + T_AB);
    const float2* tab_ab128 = (const float2*)(ws + WS_TAB + T_AB128);
    float2* Eb = (float2*)(ws + WS_E);
    const int c = lane & 31, h = lane >> 5;
    const int g = item & 31, ch = (item >> 5) % NCH, bp = item / (32 * NCH);
    const int bh = 2 * bp + h;
    const float2 a0 = tab_ab[g * 64 + c], a1 = tab_ab[g * 64 + c + 32];
    bf16x8 bfr[4];
#pragma unroll
    for (int nt = 0; nt < 4; ++nt) bfr[nt] = *(const bf16x8*)(ws + WS_TAB + T_BF + ((size_t)(g * 4 + nt) * 64 + lane) * 16);
    bf16x8 cfr[4];
    f32x4 dsk4 = (f32x4){0.f, 0.f, 0.f, 0.f};
    if (MODE != 0) {
#pragma unroll
        for (int kk = 0; kk < 4; ++kk) cfr[kk] = *(const bf16x8*)(ws + WS_TAB + T_CF + ((size_t)(g * 4 + kk) * 64 + lane) * 16);
        dsk4 = *(const f32x4*)(P.in[18] + g * 16 + 4 * (lane >> 4));
    }
    float x0r = 0.f, x0i = 0.f, x1r = 0.f, x1i = 0.f;
    if (MODE == 1) {
        const float2 p0 = tab_ab128[g * 64 + c], p1 = tab_ab128[g * 64 + c + 32];
        const float2* e0p = Eb + ((size_t)(bh * NCH) * 32 + g) * 64 + c;
        for (int cc0 = 0; cc0 < ch; cc0 += 4) {
            float2 e0[4], e1[4];
#pragma unroll
            for (int q = 0; q < 4; ++q) { const int cc = (cc0 + q < ch) ? cc0 + q : ch - 1; e0[q] = e0p[(size_t)cc * 2048]; e1[q] = e0p[(size_t)cc * 2048 + 32]; }
#pragma unroll
            for (int q = 0; q < 4; ++q) if (cc0 + q < ch) {
                const float t0r = p0.x * x0r - p0.y * x0i + e0[q].x, t0i = p0.x * x0i + p0.y * x0r + e0[q].y; x0r = t0r; x0i = t0i;
                const float t1r = p1.x * x1r - p1.y * x1i + e1[q].x, t1i = p1.x * x1i + p1.y * x1r + e1[q].y; x1r = t1r; x1i = t1i;
            }
        }
    }
    const int tok = tau32(c);
    const int arow0 = (2 * bp + (tok >> 4)) * SEQ + ch * TCH + (tok & 15);
    constexpr int NSB = TCH / 16;
#pragma unroll 1
    for (int sq4 = 0; sq4 < NSB / 4; ++sq4) {
    bf16x8 afr[4];
#pragma unroll
    for (int s4 = 0; s4 < 4; ++s4) afr[s4] = *(const bf16x8*)(pb + (size_t)(arow0 + (sq4 * 4 + s4) * 16) * PW + g * 16 + 8 * h);
#pragma unroll
    for (int s4 = 0; s4 < 4; ++s4) {
        const int sb = sq4 * 4 + s4;
        const int rb0 = (2 * bp) * SEQ + ch * TCH + sb * 16;
        const bf16x8 af = afr[s4];
        u32x2 uraw[2];
        if (MODE != 0) {
#pragma unroll
            for (int tb = 0; tb < 2; ++tb) uraw[tb] = *(const u32x2*)(pb + (size_t)(rb0 + tb * SEQ + (lane & 15)) * PW + g * 16 + 4 * (lane >> 4));
        }
        f32x16 D0, D1, D2, D3;
        {
            f32x16 zz;
#pragma unroll
            for (int i = 0; i < 16; ++i) zz[i] = 0.f;
            D0 = __builtin_amdgcn_mfma_f32_32x32x16_bf16(af, bfr[0], zz, 0, 0, 0);
            D1 = __builtin_amdgcn_mfma_f32_32x32x16_bf16(af, bfr[1], zz, 0, 0, 0);
            D2 = __builtin_amdgcn_mfma_f32_32x32x16_bf16(af, bfr[2], zz, 0, 0, 0);
            D3 = __builtin_amdgcn_mfma_f32_32x32x16_bf16(af, bfr[3], zz, 0, 0, 0);
        }
#pragma unroll
        for (int s = 0; s < 16; ++s) {
            const float n0r = a0.x * x0r - a0.y * x0i + D0[s], n0i = a0.x * x0i + a0.y * x0r + D2[s];
            const float n1r = a1.x * x1r - a1.y * x1i + D1[s], n1i = a1.x * x1i + a1.y * x1r + D3[s];
            x0r = n0r; x0i = n0i; x1r = n1r; x1i = n1i;
            D0[s] = x0r; D2[s] = x0i; D1[s] = x1r; D3[s] = x1i;
        }
        if (MODE != 0) {
#pragma unroll
            for (int s = 0; s < 16; ++s) {
                u32x2 w; w.x = cvt_pk_bf16(D0[s], D2[s]); w.y = cvt_pk_bf16(D1[s], D3[s]);
                *(LAS u32x2*)(xs + (s + 16 * h) * XS_STRIDE + c * 8) = w;
            }
            LDS_WAIT();
            const int chn = lane & 15, q = lane >> 4;
#pragma unroll
            for (int tb = 0; tb < 2; ++tb) {
                f32x4 y = (f32x4){0.f, 0.f, 0.f, 0.f};
#pragma unroll
                for (int kk = 0; kk < 4; ++kk) {
                    const bf16x8 xa = *(const LAS bf16x8*)(xs + (tb * 16 + chn) * XS_STRIDE + kk * 64 + q * 16);
                    y = __builtin_amdgcn_mfma_f32_16x16x32_bf16(cfr[kk], xa, y, 0, 0, 0);
                }
                {
                    const int row = rb0 + tb * SEQ + chn;
                    const u32x2 uu = uraw[tb];
                    const float z0 = gelu_tanh(y[0] + dsk4[0] * bflo(uu.x)), z1 = gelu_tanh(y[1] + dsk4[1] * bfhi(uu.x));
                    const float z2 = gelu_tanh(y[2] + dsk4[2] * bflo(uu.y)), z3 = gelu_tanh(y[3] + dsk4[3] * bfhi(uu.y));
                    u32x2 w; w.x = cvt_pk_bf16(z0, z1); w.y = cvt_pk_bf16(z2, z3);
                    *(u32x2*)(zb + (size_t)row * SSMW + g * 16 + 4 * q) = w;
                }
            }
            LDS_WAIT();
        }
        __builtin_amdgcn_sched_barrier(0);
    }
    }
    if (MODE == 0) {
        Eb[((size_t)(bh * NCH + ch) * 32 + g) * 64 + c] = make_float2(x0r, x0i); Eb[((size_t)(bh * NCH + ch) * 32 + g) * 64 + c + 32] = make_float2(x1r, x1i);
    }
    if (MODE == 1) {
        if (ch == NCH - 1) {
            float* ore = P.out + O_REP; float* oim = P.out + O_IMP; const size_t o = ((size_t)bh * 32 + g) * 64 + c;
            ore[o] = x0r; oim[o] = x0i; ore[o + 32] = x1r; oim[o + 32] = x1i;
        }
    }
}

__device__ __forceinline__ void conv_items(const Params& P, int it0, int it1, int stride) {
    unsigned char* ws = P.ws;
    const bf16_t* pbuf = (const bf16_t*)(ws + WS_P);
    bf16_t* mix = (bf16_t*)(ws + WS_MIX);
    const float* cw = P.in[21]; const float* scv = P.in[4];
        for (int it = it0; it < it1; it += stride) {
            const int row = it >> 6, c8 = (it & 63) * 8;
            const bf16_t* pr = pbuf + (size_t)row * PW;
            const u32x4 xc = *(const u32x4*)(pr + 512 + c8), gb = *(const u32x4*)(pr + 1024 + c8), gc = *(const u32x4*)(pr + 1536 + c8);
            float v0[8], v1[8], v2[8], gbf[8];
#pragma unroll
            for (int q = 0; q < 4; ++q) { v0[2 * q] = bflo(xc[q]) * bflo(gc[q]); v0[2 * q + 1] = bfhi(xc[q]) * bfhi(gc[q]); gbf[2 * q] = bflo(gb[q]); gbf[2 * q + 1] = bfhi(gb[q]); }
            if (row < NPROMPT) {
                const int t = row & (SEQ - 1);
                if (t >= 1) { const u32x4 x1 = *(const u32x4*)(pr - PW + 512 + c8), g1 = *(const u32x4*)(pr - PW + 1536 + c8);
#pragma unroll
                    for (int q = 0; q < 4; ++q) { v1[2 * q] = bflo(x1[q]) * bflo(g1[q]); v1[2 * q + 1] = bfhi(x1[q]) * bfhi(g1[q]); } }
                else {
#pragma unroll
                    for (int q = 0; q < 8; ++q) v1[q] = 0.f; }
                if (t >= 2) { const u32x4 x2 = *(const u32x4*)(pr - 2 * PW + 512 + c8), g2 = *(const u32x4*)(pr - 2 * PW + 1536 + c8);
#pragma unroll
                    for (int q = 0; q < 4; ++q) { v2[2 * q] = bflo(x2[q]) * bflo(g2[q]); v2[2 * q + 1] = bfhi(x2[q]) * bfhi(g2[q]); } }
                else {
#pragma unroll
                    for (int q = 0; q < 8; ++q) v2[q] = 0.f; }
                if (t == SEQ - 1) { float* o = P.out + O_CVP + (size_t)(row >> 11) * 1024 + c8;
#pragma unroll
                    for (int q = 0; q < 8; ++q) { o[q] = v1[q]; o[512 + q] = v0[q]; } }
            } else {
                const int sb = row - NPROMPT; const float* bf = scv + (size_t)sb * 1024 + c8;
#pragma unroll
                for (int q = 0; q < 8; ++q) { v2[q] = bf[q]; v1[q] = bf[512 + q]; }
                float* o = P.out + O_CVS + (size_t)sb * 1024 + c8;
#pragma unroll
                for (int q = 0; q < 8; ++q) { o[q] = v1[q]; o[512 + q] = v0[q]; }
            }
            float co[8];
#pragma unroll
            for (int q = 0; q < 8; ++q) co[q] = gbf[q] * (cw[c8 + q] * v2[q] + cw[512 + c8 + q] * v1[q] + cw[1024 + c8 + q] * v0[q]);
            u32x4 w; w.x = pk2(co[0], co[1]); w.y = pk2(co[2], co[3]); w.z = pk2(co[4], co[5]); w.w = pk2(co[6], co[7]);
            *(u32x4*)(mix + (size_t)row * DM + 512 + c8) = w;
        }
}

typedef __attribute__((address_space(1))) unsigned gu32;
#define XB_TMO      128
#define XB_XCNT(j)  (256  + 64 * (j))
#define XB_XSUB(j)  (1280 + 64 * (j))
#define XB_XGEN(j)  (2304 + 64 * (j))
#define XB_TOP      3328
#define XB_TOPGEN   3392
#define XCD_BAR_WORDS 3456
#define XB_SPIN_CAP (1u << 18)

__device__ __forceinline__ unsigned xb_ld(unsigned* p)              { return __hip_atomic_load(p, __ATOMIC_RELAXED, __HIP_MEMORY_SCOPE_AGENT); }
__device__ __forceinline__ unsigned xb_add(unsigned* p, unsigned v) { return __hip_atomic_fetch_add(p, v, __ATOMIC_RELAXED, __HIP_MEMORY_SCOPE_AGENT); }
__device__ __forceinline__ unsigned xb_xcc_id() { return (unsigned)__builtin_amdgcn_s_getreg((3 << 11) | 20) & 0xFu; }
#define XB_SPIN(cond, bar) do { unsigned _sp = 0; while (cond) { __builtin_amdgcn_s_sleep(1); \
    if ((++_sp & 255u) == 0u) { if (xb_ld(&(bar)[XB_TMO])) break; if (_sp > XB_SPIN_CAP) { atomicAdd(&(bar)[XB_TMO], 1u); break; } } } } while (0)

struct XcdBarrier {
    unsigned* bar; unsigned x;
    volatile LAS unsigned* st;
};

__device__ __forceinline__ XcdBarrier xcd_barrier_post(unsigned* bar, volatile LAS unsigned* st) {
    XcdBarrier b; b.bar = bar; b.x = xb_xcc_id(); b.st = st;
    if (threadIdx.x == 0) (void)xb_add(&bar[XB_XCNT(b.x)], 1u);
    return b;
}
__device__ __forceinline__ void xcd_barrier_complete(unsigned* bar, unsigned x, unsigned& nloc, unsigned& nx) {
    const unsigned G = gridDim.x * gridDim.y * gridDim.z;
    unsigned sum, cnt, mine, sp = 0u;
    for (;;) {
        sum = 0u; cnt = 0u; mine = 0u;
#pragma unroll
        for (unsigned j = 0; j < 16; ++j) { const unsigned c = xb_ld(&bar[XB_XCNT(j)]); sum += c; cnt += (c > 0u) ? 1u : 0u; mine = (j == x) ? c : mine; }
        if (sum == G) break;
        __builtin_amdgcn_s_sleep(1);
        if ((++sp & 255u) == 0u) { if (xb_ld(&bar[XB_TMO])) break; if (sp > XB_SPIN_CAP) { atomicAdd(&bar[XB_TMO], 1u); break; } }
    }
    nloc = mine > 0u ? mine : 1u; nx = cnt > 0u ? cnt : 1u;
}

__device__ __forceinline__ void xcd_barrier(const XcdBarrier& b) {
    asm volatile("s_waitcnt vmcnt(0)" ::: "memory");
    __syncthreads();
    if (threadIdx.x == 0) {
        unsigned* bar = b.bar;
        __builtin_amdgcn_s_waitcnt(0);
        unsigned nloc = b.st[0], nx = b.st[1];
        if (nloc == 0u) { xcd_barrier_complete(bar, b.x, nloc, nx); b.st[0] = nloc; b.st[1] = nx; }
        const unsigned old = xb_add(&bar[XB_XSUB(b.x)], 1u);
        const unsigned gen = old / nloc;
        if (old + 1u == (gen + 1u) * nloc) {
            __builtin_amdgcn_fence(__ATOMIC_RELEASE, "agent");
            asm volatile("s_waitcnt vmcnt(0)" ::: "memory");
            const unsigned og = xb_add(&bar[XB_TOP], 1u);
            const unsigned tg = og / nx;
            if (og + 1u == (tg + 1u) * nx) xb_add(&bar[XB_TOPGEN], 1u);
            else XB_SPIN(xb_ld(&bar[XB_TOPGEN]) == tg, bar);
            __builtin_amdgcn_fence(__ATOMIC_ACQUIRE, "agent");
            xb_add(&bar[XB_XGEN(b.x)], 1u);
            asm volatile("s_waitcnt vmcnt(0)" ::: "memory");
        } else {
            XB_SPIN(xb_ld(&bar[XB_XGEN(b.x)]) == gen, bar);
            __builtin_amdgcn_fence(__ATOMIC_ACQUIRE, "agent");
            asm volatile("s_waitcnt vmcnt(0)" ::: "memory");
        }
    }
    __syncthreads();
}


__global__ void __launch_bounds__(NTHREADS, 2) hymba_fwd(Params P) {
    extern __shared__ __attribute__((aligned(16))) unsigned char lds_raw[];
    LAS unsigned char* lds = (LAS unsigned char*)lds_raw;
    cg::grid_group grid = cg::this_grid();
    const int tid = threadIdx.x, lane = tid & 63, wave = __builtin_amdgcn_readfirstlane(tid >> 6);
    const int G = gridDim.x, bid = blockIdx.x;
    const int gw = bid * NWAVES + wave, NGW = G * NWAVES;
    unsigned char* ws = P.ws;
    float* ss = (float*)(ws + WS_SS);
    bf16_t* ab = (bf16_t*)(ws + WS_AB);
    bf16_t* act = (bf16_t*)(ws + WS_ACT);
    bf16_t* pbuf = (bf16_t*)(ws + WS_P);
    bf16_t* zbuf = (bf16_t*)(ws + WS_Z);
    bf16_t* mix = (bf16_t*)(ws + WS_MIX);
    const float* xp = P.in[0]; const float* xsamp = P.in[1];
    volatile LAS unsigned* bst = (volatile LAS unsigned*)(lds + 131072 + 512);
    if (tid < 2) bst[tid] = 0u;
    __syncthreads();
    XcdBarrier xbar = xcd_barrier_post((unsigned*)(ws + WS_BAR), bst);

    {
        LAS float* scr = (LAS float*)(lds + wave * 16384);
        transpose_matrix<1>(P.in[6], DM, DFF, (bf16_t*)(ws + WS_WGU1), P.in[5], scr, lane, gw, NGW);
        transpose_matrix<2>(P.in[7], DM, DFF, (bf16_t*)(ws + WS_WGU1), P.in[5], scr, lane, gw, NGW);
        for (int row0 = gw; row0 < MROWS; row0 += 2 * NGW) {
            const int row1 = row0 + NGW; const bool has1 = row1 < MROWS; const int r1c = has1 ? row1 : row0;
            const float* xr0 = row0 < NPROMPT ? xp + (size_t)row0 * DM : xsamp + (size_t)(row0 - NPROMPT) * DM;
            const float* xr1 = r1c < NPROMPT ? xp + (size_t)r1c * DM : xsamp + (size_t)(r1c - NPROMPT) * DM;
            f32x4 v0[4], v1[4];
#pragma unroll
            for (int j = 0; j < 4; ++j) { v0[j] = *(const f32x4*)(xr0 + j * 256 + lane * 4); v1[j] = *(const f32x4*)(xr1 + j * 256 + lane * 4); }
            float s0 = 0.f, s1 = 0.f;
#pragma unroll
            for (int j = 0; j < 4; ++j) {
                s0 += (v0[j][0] * v0[j][0] + v0[j][1] * v0[j][1]) + (v0[j][2] * v0[j][2] + v0[j][3] * v0[j][3]);
                s1 += (v1[j][0] * v1[j][0] + v1[j][1] * v1[j][1]) + (v1[j][2] * v1[j][2] + v1[j][3] * v1[j][3]);
                u32x2 w; w.x = cvt_pk_bf16(v0[j][0], v0[j][1]); w.y = cvt_pk_bf16(v0[j][2], v0[j][3]);
                *(u32x2*)(ab + (size_t)row0 * DM + j * 256 + lane * 4) = w;
                if (has1) { u32x2 w1; w1.x = cvt_pk_bf16(v1[j][0], v1[j][1]); w1.y = cvt_pk_bf16(v1[j][2], v1[j][3]); *(u32x2*)(ab + (size_t)row1 * DM + j * 256 + lane * 4) = w1; }
            }
            s0 = wave_sum(s0); s1 = wave_sum(s1);
            if (lane == 0) { ss[row0] = s0; if (has1) ss[row1] = s1; }
        }
        for (int i = bid * NTHREADS + tid; i < 3 * MP; i += G * NTHREADS) ss[MP + i] = 0.f;
        for (int i = bid * NTHREADS + tid; i < MP - MROWS; i += G * NTHREADS) ss[MROWS + i] = 1024.f;
        if (bid == 0 && tid < 256) ((unsigned*)(ws + WS_CNT))[tid] = 0u;
        {
            float2* t_ab = (float2*)(ws + WS_TAB + T_AB); float2* t_ab16 = (float2*)(ws + WS_TAB + T_AB16); float2* t_ab128 = (float2*)(ws + WS_TAB + T_AB128);
            const float* lre = P.in[11]; const float* lim = P.in[12]; const float* ldt = P.in[13];
            for (int i = bid * NTHREADS + tid; i < NG * NS; i += G * NTHREADS) {
                const int g = i >> 6;
                const float dt = expf(ldt[g]); const float lr = lre[i], li = lim[i];
                const float mag = expf(lr * dt); const float th = li * dt;
                float ar = mag * cosf(th), ai = mag * sinf(th);
                t_ab[i] = make_float2(ar, ai);
                float pr = ar, pi = ai;
#pragma unroll
                for (int k = 0; k < 7; ++k) { const float nr = pr * pr - pi * pi, ni = 2.f * pr * pi; pr = nr; pi = ni; if (k == 3) t_ab16[i] = make_float2(pr, pi); }
                t_ab128[i] = make_float2(pr, pi);
            }
            bf16_t* t_bf = (bf16_t*)(ws + WS_TAB + T_BF); bf16_t* t_cf = (bf16_t*)(ws + WS_TAB + T_CF);
            const float* bre = P.in[14]; const float* bim = P.in[15]; const float* cre = P.in[16]; const float* cim = P.in[17];
            for (int i = bid * NTHREADS + tid; i < NG * 4 * 64 * 8; i += G * NTHREADS) {
                const int j = i & 7, ln = (i >> 3) & 63, nt = (i >> 9) & 3, g = i >> 11;
                {
                    const int st = (nt & 1) * 32 + (ln & 31), part = nt >> 1, chn = 8 * (ln >> 5) + j;
                    const int gi = g * 64 + st;
                    const float dt = expf(ldt[g]); const float lr = lre[gi], li = lim[gi];
                    const float mag = expf(lr * dt); const float th = li * dt;
                    const float ar = mag * cosf(th), ai = mag * sinf(th);
                    const float den = lr * lr + li * li, nr = ar - 1.0f, ni = ai;
                    const float cr = (nr * lr + ni * li) / den, ci = (ni * lr - nr * li) / den;
                    const float br = bre[(size_t)gi * 16 + chn], bi = bim[(size_t)gi * 16 + chn];
                    const float v = part == 0 ? (cr * br - ci * bi) : (cr * bi + ci * br);
                    t_bf[i] = (bf16_t)f2bf(v);
                }
                {
                    const int kk = nt, k = kk * 32 + 8 * (ln >> 4) + j, chn = ln & 15, cc = k >> 2, sel = k & 3;
                    const int st = cc + ((sel >> 1) ? 32 : 0);
                    const size_t ci_ = ((size_t)g * 16 + chn) * 64 + st;
                    const float v = (sel & 1) ? -cim[ci_] : cre[ci_];
                    t_cf[i] = (bf16_t)f2bf(v);
                }
            }
        }
    }
    if (gridDim.y == 7) grid.sync();
    xcd_barrier(xbar);

    {
        pg8::Gemm g{ab, (const bf16_t*)(ws + WS_WGU1), MP, 2 * DFF, DM}; pg8::SplitOrder S; S.init(2 * DFF, DM, 1, G, bid);
        EpiGateUp E{act, ss};
        pg8::gemm_phase<EpiGateUp, pg8::SplitOrder, true, true>(lds, g, S, E, pg8::SplitCtx{nullptr, nullptr, 1});
        const int first_idle = (65 * 22) % G;
        if (bid >= first_idle) {
            LAS float* scr = (LAS float*)(lds + wave * 16384);
            const int w2 = (bid - first_idle) * NWAVES + wave, NW2 = (G - first_idle) * NWAVES;
            transpose_matrix<0>(P.in[8], DFF, DM, (bf16_t*)(ws + WS_WD1), nullptr, scr, lane, w2, NW2);
            transpose_matrix<0>(P.in[10], DM, PW, (bf16_t*)(ws + WS_WIN), P.in[9], scr, lane, w2, NW2);
            transpose_matrix<0>(P.in[19], SSMW, SSMW, (bf16_t*)(ws + WS_WGLU), nullptr, scr, lane, w2, NW2);
            transpose_matrix<0>(P.in[22], DM, DM, (bf16_t*)(ws + WS_WOUT), nullptr, scr, lane, w2, NW2);
        }
    }
    xcd_barrier(xbar);
    {
        pg8::Gemm g{act, (const bf16_t*)(ws + WS_WD1), MP, DM, DFF}; pg8::SplitOrder S; S.init(DM, DFF, 22, G, bid);
        EpiResid<false> E{xp, xsamp, ab, ss + MP, 0.5f};
        pg8::gemm_phase<EpiResid<false>, pg8::SplitOrder, true, true>(lds, g, S, E, pg8::SplitCtx{(float*)(ws + WS_PART), (unsigned*)(ws + WS_CNT), 22});
        sample_finalize<true, true, 22>((const float*)(ws + WS_PART), (unsigned*)(ws + WS_CNT), 22, 88, xsamp, P.out, ab, ss + MP, 0.5f, bid, wave, lane, tid, lds);
    }
    xcd_barrier(xbar);
    {
        pg8::Gemm g{ab, (const bf16_t*)(ws + WS_WIN), MP, PW, DM}; pg8::SplitOrder S; S.init(PW, DM, 1, G, bid, 1);
        EpiInProj E{pbuf, ss + MP};
        pg8::gemm_phase<EpiInProj, pg8::SplitOrder, true, true>(lds, g, S, E, pg8::SplitCtx{nullptr, nullptr, 1});
    }
    xcd_barrier(xbar);
    if (bid < 8) {
        pg8::Gemm g{ab, (const bf16_t*)(ws + WS_WIN), MP, PW, DM}; pg8::SplitOrder S; S.init(PW, DM, 1, G, bid, 2);
        EpiInProj E{pbuf, ss + MP};
        pg8::gemm_phase<EpiInProj, pg8::SplitOrder, true, true>(lds, g, S, E, pg8::SplitCtx{nullptr, nullptr, 1});
    } else {
        LAS unsigned char* xs = lds + wave * XS_BYTES;
        const int gw4 = (bid - 8) * NWAVES + wave, NGW4 = (G - 8) * NWAVES;
        for (int it = gw4; it < NBATCH * NCH * 32; it += NGW4) { if (((it >> 5) % NCH) != NCH - 1) ssm_item<0>(P, xs, lane, it); }
        conv_items(P, (bid - 8) * NTHREADS + tid, NPROMPT * 64, (G - 8) * NTHREADS);
    }
    xcd_barrier(xbar);
    {
        LAS unsigned char* xs = lds + wave * XS_BYTES;
        for (int it = gw; it < (NBATCH / 2) * NCH * 32 + (NSAMP / 32) * 32; it += NGW) {
            if (it < (NBATCH / 2) * NCH * 32) ssm_pair_item<1>(P, xs, lane, it); else ssm_item<2>(P, xs, lane, it - (NBATCH / 2) * NCH * 32);
        }
        conv_items(P, NPROMPT * 64 + bid * NTHREADS + tid, MROWS * 64, G * NTHREADS);
    }
    xcd_barrier(xbar);
    {
        pg8::Gemm g{zbuf, (const bf16_t*)(ws + WS_WGLU), MP, SSMW, SSMW}; pg8::SplitOrder S; S.init(SSMW, SSMW, 1, G, bid);
        EpiGlu E{zbuf, P.in[20], mix};
        pg8::gemm_phase<EpiGlu, pg8::SplitOrder, true, true>(lds, g, S, E, pg8::SplitCtx{nullptr, nullptr, 1});
        const int first_idle = (65 * 2) % G;
        if (bid >= first_idle) {
            LAS float* scr = (LAS float*)(lds + wave * 16384);
            const int w2 = (bid - first_idle) * NWAVES + wave, NW2 = (G - first_idle) * NWAVES;
            transpose_matrix<1>(P.in[24], DM, DFF, (bf16_t*)(ws + WS_WGU2), P.in[23], scr, lane, w2, NW2);
            transpose_matrix<2>(P.in[25], DM, DFF, (bf16_t*)(ws + WS_WGU2), P.in[23], scr, lane, w2, NW2);
        }
    }
    xcd_barrier(xbar);
    {
        pg8::Gemm g{mix, (const bf16_t*)(ws + WS_WOUT), MP, DM, DM}; pg8::SplitOrder S; S.init(DM, DM, 8, G, bid);
        EpiResid<false> E{xp, xsamp, ab, ss + 2 * MP, 1.0f};
        pg8::gemm_phase<EpiResid<false>, pg8::SplitOrder, true, true>(lds, g, S, E, pg8::SplitCtx{(float*)(ws + WS_PART), (unsigned*)(ws + WS_CNT) + 160, 8});
        sample_finalize<true, true, 8>((const float*)(ws + WS_PART), (unsigned*)(ws + WS_CNT) + 160, 8, 32, xsamp, P.out, ab, ss + 2 * MP, 1.0f, bid, wave, lane, tid, lds);
    }
    xcd_barrier(xbar);
    {
        pg8::Gemm g{ab, (const bf16_t*)(ws + WS_WGU2), MP, 2 * DFF, DM}; pg8::SplitOrder S; S.init(2 * DFF, DM, 1, G, bid);
        EpiGateUp E{act, ss + 2 * MP};
        pg8::gemm_phase<EpiGateUp, pg8::SplitOrder, true, true>(lds, g, S, E, pg8::SplitCtx{nullptr, nullptr, 1});
        const int first_idle = (65 * 22) % G;
        if (bid >= first_idle) {
            LAS float* scr = (LAS float*)(lds + wave * 16384);
            const int w2 = (bid - first_idle) * NWAVES + wave, NW2 = (G - first_idle) * NWAVES;
            transpose_matrix<0>(P.in[26], DFF, DM, (bf16_t*)(ws + WS_WD2), nullptr, scr, lane, w2, NW2);
        }
    }
    xcd_barrier(xbar);
    {
        pg8::Gemm g{act, (const bf16_t*)(ws + WS_WD2), MP, DM, DFF}; pg8::SplitOrder S; S.init(DM, DFF, 22, G, bid);
        EpiFinal E{P.out, ab, ss + 3 * MP, (unsigned*)(ws + WS_CNT) + 64, P.in[27], 0.5f};
        pg8::gemm_phase<EpiFinal, pg8::SplitOrder, true, true>(lds, g, S, E, pg8::SplitCtx{(float*)(ws + WS_PART), (unsigned*)(ws + WS_CNT) + 32, 22});
        sample_finalize_norm<22>((const float*)(ws + WS_PART), (unsigned*)(ws + WS_CNT) + 32, 22, 88, P.out, ab, P.in[27], 0.5f, bid, wave, lane, tid, lds);
    }
}

extern "C" void kernel_launch(void* const* d_in, const int* in_sizes, int n_in, void* d_out, int out_size, void* d_ws, size_t ws_size, hipStream_t stream) {
    static int grid_blocks = 0;
    if (grid_blocks == 0) {
        if (n_in != 28 || ws_size < WS_END) { fprintf(stderr, "kernel_launch: unexpected n_in %d / ws %zu\n", n_in, ws_size); grid_blocks = -1; return; }
        int dev = 0, cus = 0, per_cu = 0;
        hipGetDevice(&dev);
        hipDeviceGetAttribute(&cus, hipDeviceAttributeMultiprocessorCount, dev);
        if (hipFuncSetAttribute((const void*)hymba_fwd, hipFuncAttributeMaxDynamicSharedMemorySize, LDS_BYTES) != hipSuccess) { fprintf(stderr, "kernel_launch: hipFuncSetAttribute failed\n"); grid_blocks = -1; return; }
        if (hipOccupancyMaxActiveBlocksPerMultiprocessor(&per_cu, (const void*)hymba_fwd, NTHREADS, LDS_BYTES) != hipSuccess || per_cu < 1) { fprintf(stderr, "kernel_launch: occupancy query gave %d\n", per_cu); per_cu = 1; }
        (void)hipGetLastError();
        grid_blocks = cus * 1;
        fprintf(stderr, "kernel_launch: cus %d per_cu %d grid %d\n", cus, per_cu, grid_blocks);
    }
    if (grid_blocks < 0) return;
    Params p{};
    for (int i = 0; i < 28; ++i) p.in[i] = (const float*)d_in[i];
    p.out = (float*)d_out; p.ws = (unsigned char*)d_ws;
    if (hipMemsetAsync((char*)d_ws + WS_BAR, 0, 16384, stream) != hipSuccess) { fprintf(stderr, "kernel_launch: memset failed\n"); return; }
    void* args[] = {&p};
    hipError_t e = hipLaunchCooperativeKernel((const void*)hymba_fwd, dim3(grid_blocks), dim3(NTHREADS), args, LDS_BYTES, stream);
    if (e != hipSuccess) fprintf(stderr, "cooperative launch failed: %s (grid %d)\n", hipGetErrorString(e), grid_blocks);
}
```

```cpp
#include <hip/hip_runtime.h>
#include <hip/hip_cooperative_groups.h>
#include <cstdio>
#include <cstdint>
namespace cg = cooperative_groups;

#define LAS __attribute__((address_space(3)))
typedef unsigned short bf16_t;
typedef short bf16x8 __attribute__((ext_vector_type(8)));
typedef float f32x4 __attribute__((ext_vector_type(4)));
typedef float f32x16 __attribute__((ext_vector_type(16)));
typedef unsigned u32x4 __attribute__((ext_vector_type(4)));
typedef unsigned u32x2 __attribute__((ext_vector_type(2)));

constexpr int DM = 1024, NPROMPT = 16384, NSAMP = 128, MROWS = NPROMPT + NSAMP, MP = 16640, DFF = 2816, SEQ = 2048, NBATCH = 8;
constexpr int NG = 32, NS = 64, PW = 2048, SSMW = 512;
constexpr int TCH = 128, NCH = SEQ / TCH;
constexpr float EPS = 1e-6f;
constexpr int NWAVES = 8, NTHREADS = 512;
constexpr int LDS_BYTES = 147456;

constexpr size_t O_REP = (size_t)MROWS * DM, O_IMP = O_REP + 16384, O_CVP = O_IMP + 16384, O_RES = O_CVP + 8192, O_IMS = O_RES + 262144, O_CVS = O_IMS + 262144;

constexpr size_t MiB = 1u << 20;
constexpr size_t WS_SS = 0;
constexpr size_t WS_TAB = 1 * MiB;
constexpr size_t T_AB = 0, T_AB16 = 16384, T_AB128 = 32768, T_BF = 49152, T_CF = T_BF + 131072;
constexpr size_t WS_WGU1 = 4 * MiB, WS_WD1 = WS_WGU1 + 11 * MiB, WS_WIN = WS_WD1 + 5632 * 1024, WS_WGLU = WS_WIN + 4 * MiB, WS_WOUT = WS_WGLU + 512 * 1024,
                 WS_WGU2 = WS_WOUT + 2 * MiB, WS_WD2 = WS_WGU2 + 11 * MiB;
constexpr size_t WS_AB = 44 * MiB;
constexpr size_t WS_ACT = 77 * MiB;
constexpr size_t WS_P = WS_ACT, WS_Z = WS_ACT + 65 * MiB;
constexpr size_t WS_MIX = 167 * MiB;
constexpr size_t WS_E = 200 * MiB;
constexpr size_t WS_PART = 202 * MiB;
constexpr size_t WS_BAR = 768 * 1024;
constexpr size_t WS_CNT = 512 * 1024;
constexpr size_t WS_END = 214 * MiB;

struct Params { const float* in[28]; float* out; unsigned char* ws; };

__device__ __forceinline__ unsigned f2bf(float f) { unsigned u = __builtin_bit_cast(unsigned, f); return (u + 0x7fffu + ((u >> 16) & 1u)) >> 16; }
__device__ __forceinline__ unsigned cvt_pk_bf16(float lo, float hi) { unsigned r; asm("v_cvt_pk_bf16_f32 %0, %1, %2" : "=v"(r) : "v"(lo), "v"(hi)); return r; }
__device__ __forceinline__ unsigned pk2(float lo, float hi) { return cvt_pk_bf16(lo, hi); }
__device__ __forceinline__ float bf2f(unsigned short b) { return __builtin_bit_cast(float, (unsigned)b << 16); }
__device__ __forceinline__ float bflo(unsigned w) { return __builtin_bit_cast(float, w << 16); }
__device__ __forceinline__ float bfhi(unsigned w) { return __builtin_bit_cast(float, w & 0xffff0000u); }
__device__ __forceinline__ float sigmoidf_(float x) { return __builtin_amdgcn_rcpf(1.0f + __builtin_amdgcn_exp2f(-1.4426950408889634f * x)); }
__device__ __forceinline__ float gelu_tanh(float y) { const float v = 0.7978845608028654f * (y + 0.044715f * y * y * y); return y * __builtin_amdgcn_rcpf(1.0f + __builtin_amdgcn_exp2f(-2.8853900817779268f * v)); }
__device__ __forceinline__ float wave_sum(float v) {
#pragma unroll
    for (int o = 1; o < 64; o <<= 1) v += __shfl_xor(v, o);
    return v;
}
#define LDS_WAIT() asm volatile("s_waitcnt lgkmcnt(0)" ::: "memory")

namespace pg8 {
constexpr int BM = 256, BK = 64, HALF = 128, HTB = HALF * BK * 2, STAGE_BYTES = 8 * HTB, NXCD = 8, WGM = 8;
__host__ __device__ __forceinline__ int lds_byte(int r, int c) { const int st = (r >> 4) * 2 + (c >> 5), rr = r & 15, cc = c & 31, ob = rr * 64 + cc * 2; return st * 1024 + (ob ^ (((ob >> 9) & 1) << 5)); }
__host__ __device__ __forceinline__ void stage_rc(int b, int& R, int& C) { const int st = b / 1024, sb = b % 1024, swz = sb ^ (((sb >> 9) & 1) << 5); R = (st >> 1) * 16 + swz / 64; C = (st & 1) * 32 + (swz % 64) / 2; }
__host__ __device__ __forceinline__ int perm32(int rho) { const int n = rho >> 4, i = rho & 15; return 8 * (i >> 2) + 4 * n + (i & 3); }
struct Unit { int pm, pn, k0, nt, split; };
struct Gemm { const bf16_t* A; const bf16_t* Bt; int M, N, K; };
struct SplitOrder {
    int nN, nwgp, nks, ntk, ntf, G, c, which;
    __device__ void init(int N, int K, int nks_, int G_, int c_, int which_ = 0) { nN = N / BM; nwgp = 64 * nN; nks = nks_; ntf = K / BK; ntk = ntf / nks_; G = G_; c = c_; which = which_; }
    __device__ bool next(int i, Unit& u) const {
        int L = i * G + c;
        if (which == 2) { if (L >= nN) return false; u.pm = 64; u.pn = L; u.k0 = 0; u.nt = ntf; u.split = -1; return true; }
        const int nsp = nks > 1 ? nN * nks : 0;
        if (L < nsp) { const int ks = L / nN; u.pm = 64; u.pn = L % nN; u.k0 = ks * ntk; u.nt = ntk; u.split = ks; return true; }
        L -= nsp;
        if (L < nwgp) {
            const int q = nwgp / NXCD, xcd = L % NXCD, off = L / NXCD; const int wgid = xcd * q + off;
            const int nig = WGM * nN, gid = wgid / nig, fm = gid * WGM;
            u.pm = fm + ((wgid % nig) % WGM); u.pn = (wgid % nig) / WGM; u.k0 = 0; u.nt = ntf; u.split = -1; return true;
        }
        if (nks > 1 || which == 1) return false;
        const int j = L - nwgp; if (j >= nN) return false;
        u.pm = 64; u.pn = j; u.k0 = 0; u.nt = ntf; u.split = -1; return true;
    }
};
struct SplitCtx { float* part; unsigned* cnt; int nks; };
template <class Epi, class Sched, bool ALIGN_EPI, bool SP2>
__device__ __forceinline__ void gemm_phase(LAS unsigned char* lds, const Gemm g, const Sched& S, const Epi& E, const SplitCtx sc) {
    int tid_ = threadIdx.x; asm volatile("" : "+v"(tid_));
    const int tid = tid_, wid = __builtin_amdgcn_readfirstlane(tid >> 6), lane = tid & 63, wr = wid >> 2, wc = wid & 3, fr = lane & 15, fq = lane >> 4;
    const int K = g.K;
    unsigned voffA[2], voffB[2];
#pragma unroll
    for (int i = 0; i < 2; ++i) { int R, C; stage_rc(tid * 16 + i * 8192, R, C); const int Rb = Epi::PERM ? ((R & ~31) + perm32(R & 31)) : R;
        voffA[i] = (unsigned)(R * K + C) * 2u; voffB[i] = (unsigned)(Rb * K + C) * 2u; }
    const size_t kstep = (size_t)(BK * 2);
    const size_t hstep = (size_t)HALF * K * 2;
    const size_t tstep = 2 * hstep;
    const unsigned ldsw = (unsigned)wid * 1024u;
    const int aoff = lds_byte(wr * 64 + fr, fq * 8), boff = lds_byte(wc * 32 + fr, fq * 8);
#define PG8_SA(b, h) (((b) * 2 + (h)) * HTB)
#define PG8_SB(b, h) ((4 + (b) * 2 + (h)) * HTB)
#define PG8_STAGE(bufoff, gbase, voff) do { _Pragma("unroll") for (int _i = 0; _i < 2; ++_i) \
        __builtin_amdgcn_global_load_lds((const unsigned*)((const char*)(gbase) + (voff)[_i]), (LAS unsigned*)(lds + (bufoff) + ldsw + _i * 8192), 16, 0, 0); } while (0)
#define PG8_LDA(dst, b, h) do { _Pragma("unroll") for (int m = 0; m < 4; ++m) _Pragma("unroll") for (int k = 0; k < 2; ++k) dst[m][k] = *(const LAS bf16x8*)(lds + PG8_SA(b, h) + aoff + m * 2048 + k * 1024); } while (0)
#define PG8_LDB(dst, b, h) do { _Pragma("unroll") for (int n = 0; n < 2; ++n) _Pragma("unroll") for (int k = 0; k < 2; ++k) dst[n][k] = *(const LAS bf16x8*)(lds + PG8_SB(b, h) + boff + n * 2048 + k * 1024); } while (0)
#define PG8_MMA(ai, bj, At, Bt) do { __builtin_amdgcn_s_setprio(1); _Pragma("unroll") for (int m = 0; m < 4; ++m) _Pragma("unroll") for (int n = 0; n < 2; ++n) _Pragma("unroll") for (int k = 0; k < 2; ++k) \
        acc[ai][bj][m][n] = __builtin_amdgcn_mfma_f32_16x16x32_bf16(Bt[n][k], At[m][k], acc[ai][bj][m][n], 0, 0, 0); __builtin_amdgcn_s_setprio(0); } while (0)
#define PG8_WAIT_V(n) asm volatile("s_waitcnt vmcnt(" #n ")" ::: "memory")
#define PG8_WAIT_L(n) asm volatile("s_waitcnt lgkmcnt(" #n ")" ::: "memory")
#define PG8_BAR __builtin_amdgcn_s_barrier()
#define PG8_SCHED __builtin_amdgcn_sched_barrier(0)
    Unit cur, nxt; int ui = 0;
    if (!S.next(0, cur)) return;
    f32x4 acc[2][2][4][2];
#pragma unroll
    for (int a = 0; a < 2; ++a)
#pragma unroll
        for (int b = 0; b < 2; ++b)
#pragma unroll
            for (int m = 0; m < 4; ++m)
#pragma unroll
                for (int n = 0; n < 2; ++n) acc[a][b][m][n] = (f32x4){0.f, 0.f, 0.f, 0.f};
    bf16x8 At[4][2], B0[2][2], B1[2][2];
    const char* cA = (const char*)g.A + (size_t)cur.pm * tstep + (size_t)cur.k0 * kstep; const char* cB = (const char*)g.Bt + (size_t)cur.pn * tstep + (size_t)cur.k0 * kstep;
    if constexpr (SP2) {
        PG8_STAGE(PG8_SB(0, 0), cB, voffB); PG8_STAGE(PG8_SB(0, 1), cB + hstep, voffB); PG8_STAGE(PG8_SA(0, 0), cA, voffA); PG8_STAGE(PG8_SA(0, 1), cA + hstep, voffA);
        if (wr == 1) PG8_BAR;
        PG8_WAIT_V(2); PG8_BAR;
        PG8_STAGE(PG8_SB(1, 0), cB + kstep, voffB); PG8_STAGE(PG8_SA(1, 0), cA + kstep, voffA); PG8_STAGE(PG8_SB(1, 1), cB + hstep + kstep, voffB);
        PG8_WAIT_V(6); PG8_BAR;
    } else {
        PG8_STAGE(PG8_SB(0, 0), cB, voffB); PG8_STAGE(PG8_SA(0, 0), cA, voffA); PG8_STAGE(PG8_SB(0, 1), cB + hstep, voffB); PG8_STAGE(PG8_SA(0, 1), cA + hstep, voffA);
        if (wr == 1) PG8_BAR;
        PG8_WAIT_V(4); PG8_BAR;
        PG8_STAGE(PG8_SB(1, 0), cB + kstep, voffB); PG8_STAGE(PG8_SA(1, 0), cA + kstep, voffA); PG8_STAGE(PG8_SB(1, 1), cB + hstep + kstep, voffB);
        PG8_WAIT_V(6); PG8_BAR;
    }
    for (;;) {
        const bool has_next = S.next(ui + 1, nxt);
        const char* nA = has_next ? (const char*)g.A + (size_t)nxt.pm * tstep + (size_t)nxt.k0 * kstep : cA; const char* nB = has_next ? (const char*)g.Bt + (size_t)nxt.pn * tstep + (size_t)nxt.k0 * kstep : cB;
        const int nt = cur.nt;
        for (int t = 0; t < nt; t += 2) {
            const bool last = (t == nt - 2);
            const char* a1 = cA + (size_t)(t + 1) * kstep;
            const char* a2 = last ? nA : cA + (size_t)(t + 2) * kstep; const char* b2 = last ? nB : cB + (size_t)(t + 2) * kstep;
            const char* a3 = a2 + kstep; const char* b3 = b2 + kstep;
            if constexpr (SP2) {
            PG8_LDB(B0, 0, 0); PG8_LDB(B1, 0, 1); PG8_SCHED; PG8_LDA(At, 0, 0); PG8_STAGE(PG8_SA(1, 1), a1 + hstep, voffA);
            PG8_WAIT_V(8); PG8_WAIT_L(0); PG8_BAR; PG8_MMA(0, 0, At, B0); PG8_MMA(0, 1, At, B1); PG8_BAR; PG8_SCHED;
            PG8_LDA(At, 0, 1); PG8_STAGE(PG8_SB(0, 0), b2, voffB); PG8_STAGE(PG8_SB(0, 1), b2 + hstep, voffB); PG8_STAGE(PG8_SA(0, 0), a2, voffA);
            PG8_WAIT_V(8); PG8_WAIT_L(0); PG8_BAR; PG8_MMA(1, 0, At, B0); PG8_MMA(1, 1, At, B1); PG8_BAR; PG8_SCHED;
            PG8_LDB(B0, 1, 0); PG8_LDB(B1, 1, 1); PG8_SCHED; PG8_LDA(At, 1, 0); PG8_STAGE(PG8_SA(0, 1), a2 + hstep, voffA);
            PG8_WAIT_V(8); PG8_WAIT_L(0); PG8_BAR; PG8_MMA(0, 0, At, B0); PG8_MMA(0, 1, At, B1); PG8_BAR; PG8_SCHED;
            PG8_LDA(At, 1, 1); PG8_STAGE(PG8_SB(1, 0), b3, voffB); PG8_STAGE(PG8_SB(1, 1), b3 + hstep, voffB); PG8_STAGE(PG8_SA(1, 0), a3, voffA);
            PG8_WAIT_V(8); PG8_WAIT_L(0); PG8_BAR; PG8_MMA(1, 0, At, B0); PG8_MMA(1, 1, At, B1); PG8_BAR; PG8_SCHED;
            } else {
            PG8_LDB(B0, 0, 0); PG8_SCHED; PG8_LDA(At, 0, 0); PG8_STAGE(PG8_SA(1, 1), a1 + hstep, voffA);
            PG8_WAIT_L(8); PG8_BAR; PG8_WAIT_L(0); PG8_MMA(0, 0, At, B0); PG8_BAR; PG8_SCHED;
            PG8_LDB(B1, 0, 1); PG8_STAGE(PG8_SB(0, 0), b2, voffB);
            PG8_BAR; PG8_WAIT_L(0); PG8_MMA(0, 1, At, B1); PG8_BAR;
            PG8_LDA(At, 0, 1); PG8_STAGE(PG8_SA(0, 0), a2, voffA);
            PG8_BAR; PG8_WAIT_L(0); PG8_MMA(1, 0, At, B0); PG8_BAR; PG8_SCHED;
            PG8_STAGE(PG8_SB(0, 1), b2 + hstep, voffB);
            PG8_WAIT_V(6); PG8_BAR; PG8_MMA(1, 1, At, B1); PG8_BAR;
            PG8_LDB(B0, 1, 0); PG8_SCHED; PG8_LDA(At, 1, 0); PG8_STAGE(PG8_SA(0, 1), a2 + hstep, voffA);
            PG8_WAIT_L(8); PG8_BAR; PG8_WAIT_L(0); PG8_MMA(0, 0, At, B0); PG8_BAR; PG8_SCHED;
            PG8_LDB(B1, 1, 1); PG8_STAGE(PG8_SB(1, 0), b3, voffB);
            PG8_BAR; PG8_WAIT_L(0); PG8_MMA(0, 1, At, B1); PG8_BAR;
            PG8_LDA(At, 1, 1); PG8_STAGE(PG8_SA(1, 0), a3, voffA);
            PG8_BAR; PG8_WAIT_L(0); PG8_MMA(1, 0, At, B0); PG8_BAR; PG8_SCHED;
            PG8_STAGE(PG8_SB(1, 1), b3 + hstep, voffB);
            PG8_WAIT_V(6); PG8_BAR; PG8_MMA(1, 1, At, B1); PG8_BAR;
            }
        }
        if constexpr (ALIGN_EPI) { if (wr == 0) PG8_BAR; }
        if (cur.split < 0) E(acc, cur, wr, wc, fr, fq);
        else {
            float* slab = sc.part + (size_t)cur.split * (128 * g.N) + cur.pn * 256;
#pragma unroll
            for (int m = 0; m < 4; ++m)
#pragma unroll
                for (int bj = 0; bj < 2; ++bj)
#pragma unroll
                    for (int n = 0; n < 2; ++n) *(f32x4*)(slab + (size_t)(wr * 64 + m * 16 + fr) * g.N + bj * 128 + wc * 32 + (Epi::PERM ? 8 * fq + 4 * n : n * 16 + 4 * fq)) = acc[0][bj][m][n];
            asm volatile("s_waitcnt vmcnt(0) lgkmcnt(0)" ::: "memory"); __builtin_amdgcn_s_barrier(); asm volatile("" ::: "memory");
            if (tid == 0) {
                __builtin_amdgcn_fence(__ATOMIC_RELEASE, "agent");
                asm volatile("s_waitcnt vmcnt(0)" ::: "memory");
                __hip_atomic_fetch_add(sc.cnt, 1u, __ATOMIC_RELAXED, __HIP_MEMORY_SCOPE_AGENT);
            }
        }
        if (!has_next) break;
#pragma unroll
        for (int a = 0; a < 2; ++a)
#pragma unroll
            for (int b = 0; b < 2; ++b)
#pragma unroll
                for (int m = 0; m < 4; ++m)
#pragma unroll
                    for (int n = 0; n < 2; ++n) acc[a][b][m][n] = (f32x4){0.f, 0.f, 0.f, 0.f};
        cur = nxt; cA = nA; cB = nB; ++ui;
        if constexpr (ALIGN_EPI) { if (wr == 1) PG8_BAR; }
    }
    PG8_WAIT_V(0);
    if constexpr (!ALIGN_EPI) { if (wr == 0) PG8_BAR; }
    PG8_BAR;
#undef PG8_SA
#undef PG8_SB
#undef PG8_STAGE
#undef PG8_LDA
#undef PG8_LDB
#undef PG8_MMA
#undef PG8_WAIT_V
#undef PG8_WAIT_L
#undef PG8_BAR
#undef PG8_SCHED
}
}

struct EpiGateUp {
    static constexpr bool PERM = true;
    bf16_t* act; const float* ss;
    __device__ __forceinline__ void operator()(const f32x4 (&acc)[2][2][4][2], const pg8::Unit& u, int wr, int wc, int fr, int fq) const {
        float ssv[2][4];
#pragma unroll
        for (int ai = 0; ai < 2; ++ai)
#pragma unroll
            for (int m = 0; m < 4; ++m) ssv[ai][m] = ss[u.pm * 256 + ai * 128 + wr * 64 + m * 16 + fr];
#pragma unroll
        for (int ai = 0; ai < 2; ++ai)
#pragma unroll
            for (int m = 0; m < 4; ++m) {
                const int row = u.pm * 256 + ai * 128 + wr * 64 + m * 16 + fr;
                const float rs = __builtin_amdgcn_rsqf(ssv[ai][m] * (1.0f / DM) + EPS);
                float v[8];
#pragma unroll
                for (int n = 0; n < 2; ++n)
#pragma unroll
                    for (int i = 0; i < 4; ++i) { const float gt = acc[ai][0][m][n][i] * rs, up = acc[ai][1][m][n][i] * rs; v[n * 4 + i] = gt * sigmoidf_(gt) * up; }
                u32x4 w; w.x = pk2(v[0], v[1]); w.y = pk2(v[2], v[3]); w.z = pk2(v[4], v[5]); w.w = pk2(v[6], v[7]);
                *(u32x4*)(act + (size_t)row * DFF + u.pn * 128 + wc * 32 + 8 * fq) = w;
            }
    }
};
template <bool BASE_X> struct EpiResid {
    static constexpr bool PERM = true;
    const float* xp; const float* xs; bf16_t* hb; float* ssn; float scale;
    __device__ __forceinline__ void operator()(const f32x4 (&acc)[2][2][4][2], const pg8::Unit& u, int wr, int wc, int fr, int fq) const {
#pragma unroll
        for (int ai = 0; ai < 2; ++ai) {
            u32x2 hw[4][2][2];
#pragma unroll
            for (int m = 0; m < 4; ++m) {
                const int row = u.pm * 256 + ai * 128 + wr * 64 + m * 16 + fr;
#pragma unroll
                for (int bj = 0; bj < 2; ++bj)
#pragma unroll
                    for (int n = 0; n < 2; ++n) hw[m][bj][n] = *(const u32x2*)(hb + (size_t)row * DM + u.pn * 256 + bj * 128 + wc * 32 + 8 * fq + 4 * n);
            }
#pragma unroll
            for (int m = 0; m < 4; ++m) {
                const int row = u.pm * 256 + ai * 128 + wr * 64 + m * 16 + fr;
                float sq = 0.f;
#pragma unroll
                for (int bj = 0; bj < 2; ++bj)
#pragma unroll
                    for (int n = 0; n < 2; ++n) {
                        const int col = u.pn * 256 + bj * 128 + wc * 32 + 8 * fq + 4 * n;
                        const u32x2 h2 = hw[m][bj][n];
                        const f32x4 hv = (f32x4){bflo(h2.x), bfhi(h2.x), bflo(h2.y), bfhi(h2.y)} + acc[ai][bj][m][n] * scale;
                        u32x2 w; w.x = pk2(hv[0], hv[1]); w.y = pk2(hv[2], hv[3]);
                        *(u32x2*)(hb + (size_t)row * DM + col) = w;
                        sq += (hv[0] * hv[0] + hv[1] * hv[1]) + (hv[2] * hv[2] + hv[3] * hv[3]);
                    }
                sq += __shfl_xor(sq, 16); sq += __shfl_xor(sq, 32);
                if (fq == 0) atomicAdd(ssn + row, sq);
            }
        }
    }
};
struct EpiFinal {
    static constexpr bool PERM = true;
    float* out; const bf16_t* hb; float* ssn; unsigned* pcnt; const float* gamma; float scale;
    __device__ __forceinline__ void operator()(f32x4 (&acc)[2][2][4][2], const pg8::Unit& u, int wr, int wc, int fr, int fq) const {
#pragma unroll
        for (int ai = 0; ai < 2; ++ai) {
            u32x2 hwv[4][2][2];
#pragma unroll
            for (int m = 0; m < 4; ++m) {
                const int row = u.pm * 256 + ai * 128 + wr * 64 + m * 16 + fr;
#pragma unroll
                for (int bj = 0; bj < 2; ++bj)
#pragma unroll
                    for (int n = 0; n < 2; ++n) hwv[m][bj][n] = *(const u32x2*)(hb + (size_t)row * DM + u.pn * 256 + bj * 128 + wc * 32 + 8 * fq + 4 * n);
            }
#pragma unroll
            for (int m = 0; m < 4; ++m) {
                const int row = u.pm * 256 + ai * 128 + wr * 64 + m * 16 + fr;
                float sq = 0.f;
#pragma unroll
                for (int bj = 0; bj < 2; ++bj)
#pragma unroll
                    for (int n = 0; n < 2; ++n) {
                        const u32x2 hw = hwv[m][bj][n];
                        const f32x4 hv = (f32x4){bflo(hw.x), bfhi(hw.x), bflo(hw.y), bfhi(hw.y)} + acc[ai][bj][m][n] * scale;
                        acc[ai][bj][m][n] = hv;
                        sq += (hv[0] * hv[0] + hv[1] * hv[1]) + (hv[2] * hv[2] + hv[3] * hv[3]);
                    }
                sq += __shfl_xor(sq, 16); sq += __shfl_xor(sq, 32);
                if (fq == 0) atomicAdd(ssn + row, sq);
            }
        }
        asm volatile("s_waitcnt vmcnt(0) lgkmcnt(0)" ::: "memory"); __builtin_amdgcn_s_barrier(); asm volatile("" ::: "memory");
        if (wr == 0 && wc == 0 && fr == 0 && fq == 0) {
            __builtin_amdgcn_fence(__ATOMIC_RELEASE, "agent");
            asm volatile("s_waitcnt vmcnt(0)" ::: "memory");
            __hip_atomic_fetch_add(pcnt + u.pm, 1u, __ATOMIC_RELAXED, __HIP_MEMORY_SCOPE_AGENT);
            unsigned sp = 0;
            while (__hip_atomic_load(pcnt + u.pm, __ATOMIC_RELAXED, __HIP_MEMORY_SCOPE_AGENT) < 4u) { __builtin_amdgcn_s_sleep(1); if (++sp > (1u << 22)) break; }
            __builtin_amdgcn_fence(__ATOMIC_ACQUIRE, "agent");
            asm volatile("s_waitcnt vmcnt(0)" ::: "memory");
        }
        asm volatile("s_waitcnt vmcnt(0) lgkmcnt(0)" ::: "memory"); __builtin_amdgcn_s_barrier(); asm volatile("" ::: "memory");
        float sv[2][4]; f32x4 gnv[2][2];
#pragma unroll
        for (int ai = 0; ai < 2; ++ai)
#pragma unroll
            for (int m = 0; m < 4; ++m) sv[ai][m] = __hip_atomic_load(ssn + u.pm * 256 + ai * 128 + wr * 64 + m * 16 + fr, __ATOMIC_RELAXED, __HIP_MEMORY_SCOPE_AGENT);
#pragma unroll
        for (int bj = 0; bj < 2; ++bj)
#pragma unroll
            for (int n = 0; n < 2; ++n) gnv[bj][n] = *(const f32x4*)(gamma + u.pn * 256 + bj * 128 + wc * 32 + 8 * fq + 4 * n);
#pragma unroll
        for (int ai = 0; ai < 2; ++ai)
#pragma unroll
            for (int m = 0; m < 4; ++m) {
                const int row = u.pm * 256 + ai * 128 + wr * 64 + m * 16 + fr;
                const float rs = __builtin_amdgcn_rsqf(sv[ai][m] * (1.0f / DM) + EPS);
#pragma unroll
                for (int bj = 0; bj < 2; ++bj)
#pragma unroll
                    for (int n = 0; n < 2; ++n) {
                        const int col = u.pn * 256 + bj * 128 + wc * 32 + 8 * fq + 4 * n;
                        *(f32x4*)(out + (size_t)row * DM + col) = acc[ai][bj][m][n] * rs * gnv[bj][n];
                    }
            }
    }
};
struct EpiInProj {
    static constexpr bool PERM = true;
    bf16_t* p; const float* ss;
    __device__ __forceinline__ void operator()(const f32x4 (&acc)[2][2][4][2], const pg8::Unit& u, int wr, int wc, int fr_, int fq_) const {
        int fr = fr_, fq = fq_; asm volatile("" : "+v"(fr), "+v"(fq));
#pragma unroll
        for (int ai = 0; ai < 2; ++ai)
#pragma unroll
            for (int m = 0; m < 4; ++m) {
                const int row = u.pm * 256 + ai * 128 + wr * 64 + m * 16 + fr;
                const float rs = __builtin_amdgcn_rsqf(ss[row] * (1.0f / DM) + EPS);
                if (u.pn < 4) {
#pragma unroll
                    for (int bj = 0; bj < 2; ++bj) {
                        const f32x4 a = acc[ai][bj][m][0] * rs, b = acc[ai][bj][m][1] * rs;
                        u32x4 w; w.x = pk2(a[0], a[1]); w.y = pk2(a[2], a[3]); w.z = pk2(b[0], b[1]); w.w = pk2(b[2], b[3]);
                        *(u32x4*)(p + (size_t)row * PW + u.pn * 256 + bj * 128 + wc * 32 + 8 * fq) = w;
                    }
                } else {
                    const float r2 = rs * rs;
                    const f32x4 a = acc[ai][0][m][0] * acc[ai][1][m][0] * r2, b = acc[ai][0][m][1] * acc[ai][1][m][1] * r2;
                    u32x4 w; w.x = pk2(a[0], a[1]); w.y = pk2(a[2], a[3]); w.z = pk2(b[0], b[1]); w.w = pk2(b[2], b[3]);
                    *(u32x4*)(p + (size_t)row * PW + 1024 + (u.pn - 4) * 128 + wc * 32 + 8 * fq) = w;
                }
            }
    }
};
struct EpiGlu {
    static constexpr bool PERM = true;
    const bf16_t* z; const float* bias; bf16_t* mix;
    __device__ __forceinline__ void operator()(const f32x4 (&acc)[2][2][4][2], const pg8::Unit& u, int wr, int wc, int fr, int fq) const {
#pragma unroll
        for (int bj = 0; bj < 2; ++bj) {
            const int col = u.pn * 256 + bj * 128 + wc * 32 + 8 * fq;
            const f32x4 b0 = *(const f32x4*)(bias + col), b1 = *(const f32x4*)(bias + col + 4);
            u32x4 zv[2][4];
#pragma unroll
            for (int ai = 0; ai < 2; ++ai)
#pragma unroll
                for (int m = 0; m < 4; ++m) zv[ai][m] = *(const u32x4*)(z + (size_t)(u.pm * 256 + ai * 128 + wr * 64 + m * 16 + fr) * SSMW + col);
#pragma unroll
            for (int ai = 0; ai < 2; ++ai)
#pragma unroll
                for (int m = 0; m < 4; ++m) {
                    const int row = u.pm * 256 + ai * 128 + wr * 64 + m * 16 + fr;
                    const u32x4 zz = zv[ai][m];
                    const f32x4 a = acc[ai][bj][m][0] + b0, b = acc[ai][bj][m][1] + b1;
                    u32x4 w;
                    w.x = pk2(bflo(zz.x) * sigmoidf_(a[0]), bfhi(zz.x) * sigmoidf_(a[1]));
                    w.y = pk2(bflo(zz.y) * sigmoidf_(a[2]), bfhi(zz.y) * sigmoidf_(a[3]));
                    w.z = pk2(bflo(zz.z) * sigmoidf_(b[0]), bfhi(zz.z) * sigmoidf_(b[1]));
                    w.w = pk2(bflo(zz.w) * sigmoidf_(b[2]), bfhi(zz.w) * sigmoidf_(b[3]));
                    *(u32x4*)(mix + (size_t)row * DM + col) = w;
                }
        }
    }
};

template <bool BASE_X, bool WRITE_HB, int NKS>
__device__ __forceinline__ void sample_finalize(const float* part, unsigned* cnt, int nks, int nsplit_units, const float* xs, float* out, bf16_t* hb, float* ssn, float scale,
                                                int bid, int wave, int lane, int tid, LAS unsigned char* lds) {
    if (bid >= 128) return;
    if (tid == 0) {
        unsigned sp = 0;
        while (__hip_atomic_load(cnt, __ATOMIC_RELAXED, __HIP_MEMORY_SCOPE_AGENT) < (unsigned)nsplit_units) { __builtin_amdgcn_s_sleep(2); if (++sp > (1u << 22)) break; }
        __builtin_amdgcn_fence(__ATOMIC_ACQUIRE, "agent");
        asm volatile("s_waitcnt vmcnt(0)" ::: "memory");
    }
    __syncthreads();
    if (wave < 4) {
        const int r = bid, col = wave * 256 + lane * 4, row = NPROMPT + r;
        f32x4 pv[NKS];
#pragma unroll
        for (int ks = 0; ks < NKS; ++ks) pv[ks] = *(const f32x4*)(part + ((size_t)ks * 128 + r) * DM + col);
        f32x4 s = (f32x4){0.f, 0.f, 0.f, 0.f};
#pragma unroll
        for (int ks = 0; ks < NKS; ++ks) s += pv[ks];
        f32x4 hv; { const u32x2 hw = *(const u32x2*)(hb + (size_t)row * DM + col); hv = (f32x4){bflo(hw.x), bfhi(hw.x), bflo(hw.y), bfhi(hw.y)} + s * scale; }
        if (WRITE_HB) { u32x2 w; w.x = pk2(hv[0], hv[1]); w.y = pk2(hv[2], hv[3]); *(u32x2*)(hb + (size_t)row * DM + col) = w; }
        float sq = (hv[0] * hv[0] + hv[1] * hv[1]) + (hv[2] * hv[2] + hv[3] * hv[3]);
        sq = wave_sum(sq);
        if (lane == 0) atomicAdd(ssn + row, sq);
    }
}

template <int NKS>
__device__ __forceinline__ void sample_finalize_norm(const float* part, unsigned* cnt, int nks, int nsplit_units, float* out, const bf16_t* hb, const float* gamma, float scale,
                                                     int bid, int wave, int lane, int tid, LAS unsigned char* lds) {
    if (bid >= 128) return;
    if (tid == 0) {
        unsigned sp = 0;
        while (__hip_atomic_load(cnt, __ATOMIC_RELAXED, __HIP_MEMORY_SCOPE_AGENT) < (unsigned)nsplit_units) { __builtin_amdgcn_s_sleep(2); if (++sp > (1u << 22)) break; }
        __builtin_amdgcn_fence(__ATOMIC_ACQUIRE, "agent");
        asm volatile("s_waitcnt vmcnt(0)" ::: "memory");
    }
    __syncthreads();
    LAS float* red = (LAS float*)(lds + 131072 + 1024);
    const int r = bid, col = (wave & 3) * 256 + lane * 4, row = NPROMPT + r;
    f32x4 hv = (f32x4){0.f, 0.f, 0.f, 0.f};
    if (wave < 4) {
        f32x4 pv[NKS];
#pragma unroll
        for (int ks = 0; ks < NKS; ++ks) pv[ks] = *(const f32x4*)(part + ((size_t)ks * 128 + r) * DM + col);
        f32x4 s = (f32x4){0.f, 0.f, 0.f, 0.f};
#pragma unroll
        for (int ks = 0; ks < NKS; ++ks) s += pv[ks];
        { const u32x2 hw = *(const u32x2*)(hb + (size_t)row * DM + col); hv = (f32x4){bflo(hw.x), bfhi(hw.x), bflo(hw.y), bfhi(hw.y)} + s * scale; }
        float sq = (hv[0] * hv[0] + hv[1] * hv[1]) + (hv[2] * hv[2] + hv[3] * hv[3]);
        sq = wave_sum(sq);
        if (lane == 0) red[wave] = sq;
    }
    __syncthreads();
    if (wave < 4) {
        const float tot = (red[0] + red[1]) + (red[2] + red[3]);
        const float rs = __builtin_amdgcn_rsqf(tot * (1.0f / DM) + EPS);
        const f32x4 gn = *(const f32x4*)(gamma + col);
        *(f32x4*)(out + (size_t)row * DM + col) = hv * rs * gn;
    }
}

__device__ __forceinline__ void transpose_item(const float* W, int N, int k0, int n0, bf16_t* WT, int K, int drow0, const float* gain, LAS float* scr, int lane) {
    float wv[32];
    const float* wp = W + (size_t)(k0 + (lane >> 5)) * N + n0 + (lane & 31);
#pragma unroll
    for (int i = 0; i < 32; ++i) wv[i] = wp[(size_t)(2 * i) * N];
    const float gsc = gain ? gain[k0 + lane] : 1.0f;
#pragma unroll
    for (int i = 0; i < 32; ++i) { const int kk = 2 * i + (lane >> 5); scr[kk * 33 + (lane & 31)] = wv[i] * __shfl(gsc, kk); }
    LDS_WAIT();
    const int c = lane & 7;
#pragma unroll
    for (int j = 0; j < 4; ++j) { const int n = (lane >> 3) + 8 * j; const LAS float* s = scr + (8 * c) * 33 + n;
        u32x4 o; o.x = pk2(s[0 * 33], s[1 * 33]); o.y = pk2(s[2 * 33], s[3 * 33]); o.z = pk2(s[4 * 33], s[5 * 33]); o.w = pk2(s[6 * 33], s[7 * 33]);
        *(u32x4*)(WT + (size_t)(drow0 + n) * K + k0 + 8 * c) = o; }
    LDS_WAIT();
}
template <int GU>
__device__ __forceinline__ void transpose_matrix(const float* W, int K, int N, bf16_t* WT, const float* gain, LAS float* scr, int lane, int gw, int NGW) {
    const int nblk = N / 32, nitems = (K / 64) * nblk;
    for (int it = gw; it < nitems; it += NGW) {
        const int kb = it / nblk, nb = it % nblk, n0 = nb * 32;
        int drow0;
        if (GU == 0) drow0 = n0;
        else if (GU == 3) {
            const int seg = n0 >> 9, j = n0 & 511;
            drow0 = seg == 0 ? j : seg == 2 ? 512 + j : (4 + (j >> 7)) * 256 + (j & 127) + (seg == 3 ? 128 : 0);
        } else drow0 = 256 * (n0 / 128) + (n0 % 128) + (GU == 2 ? 128 : 0);
        transpose_item(W, N, kb * 64, n0, WT, K, drow0, gain, scr, lane);
    }
}

__device__ __forceinline__ int tau32(int r) { return (r & 3) + 4 * (r >> 3) + 16 * ((r >> 2) & 1); }
constexpr int XS_STRIDE = 272, XS_BYTES = 32 * XS_STRIDE;

template <int MODE>
__device__ __forceinline__ void ssm_item(const Params& P, LAS unsigned char* xs, int lane, int item) {
    unsigned char* ws = P.ws;
    const bf16_t* pb = (const bf16_t*)(ws + WS_P);
    bf16_t* zb = (bf16_t*)(ws + WS_Z);
    const float2* tab_ab = (const float2*)(ws + WS_TAB + T_AB);
    const float2* tab_ab16 = (const float2*)(ws + WS_TAB + T_AB16);
    const float2* tab_ab128 = (const float2*)(ws + WS_TAB + T_AB128);
    float2* Eb = (float2*)(ws + WS_E);
    const int c = lane & 31, h = lane >> 5;
    int g, b = 0, ch = 0, row0, nblk;
    if (MODE == 2) { g = item & 31; const int sb = item >> 5; row0 = NPROMPT + sb * 32; nblk = 1; b = sb * 32; }
    else { g = item & 31; ch = (item >> 5) % NCH; b = item / (32 * NCH); row0 = b * SEQ + ch * TCH; nblk = TCH / 32; }
    const float2 a0 = tab_ab[g * 64 + c], a1 = tab_ab[g * 64 + c + 32];
    bf16x8 bfr[4];
#pragma unroll
    for (int nt = 0; nt < 4; ++nt) bfr[nt] = *(const bf16x8*)(ws + WS_TAB + T_BF + ((size_t)(g * 4 + nt) * 64 + lane) * 16);
    bf16x8 cfr[4];
    float dsk = 0.f;
    if (MODE != 0) {
#pragma unroll
        for (int kk = 0; kk < 4; ++kk) cfr[kk] = *(const bf16x8*)(ws + WS_TAB + T_CF + ((size_t)(g * 4 + kk) * 64 + lane) * 16);
        dsk = P.in[18][g * 16 + (lane & 15)];
    }
    float X0r = 0.f, X0i = 0.f, X1r = 0.f, X1i = 0.f;
    if (MODE == 1) {
        const float2 p0 = tab_ab128[g * 64 + c], p1 = tab_ab128[g * 64 + c + 32];
        const float2* e0p = Eb + ((size_t)(b * NCH) * 32 + g) * 64 + c;
        for (int cc0 = 0; cc0 < ch; cc0 += 4) {
            float2 e0[4], e1[4];
#pragma unroll
            for (int q = 0; q < 4; ++q) { const int cc = (cc0 + q < ch) ? cc0 + q : ch - 1; e0[q] = e0p[(size_t)cc * 2048]; e1[q] = e0p[(size_t)cc * 2048 + 32]; }
#pragma unroll
            for (int q = 0; q < 4; ++q) if (cc0 + q < ch) {
                const float t0r = p0.x * X0r - p0.y * X0i + e0[q].x, t0i = p0.x * X0i + p0.y * X0r + e0[q].y; X0r = t0r; X0i = t0i;
                const float t1r = p1.x * X1r - p1.y * X1i + e1[q].x, t1i = p1.x * X1i + p1.y * X1r + e1[q].y; X1r = t1r; X1i = t1i;
            }
        }
    }
    const int tok = tau32(c);
    constexpr int NBLK = (MODE == 2) ? 1 : TCH / 32;
    bf16x8 afr[NBLK];
#pragma unroll
    for (int blk = 0; blk < NBLK; ++blk) afr[blk] = *(const bf16x8*)(pb + (size_t)(row0 + blk * 32 + tok) * PW + g * 16 + 8 * h);
#pragma unroll
    for (int blk = 0; blk < NBLK; ++blk) {
        const int rb = row0 + blk * 32;
        const bf16x8 af = afr[blk];
        unsigned short uraw[8];
        if (MODE != 0) {
#pragma unroll
            for (int tb = 0; tb < 2; ++tb)
#pragma unroll
                for (int r = 0; r < 4; ++r) uraw[tb * 4 + r] = pb[(size_t)(rb + tb * 16 + 4 * (lane >> 4) + r) * PW + g * 16 + (lane & 15)];
        }
        f32x16 D0, D1, D2, D3;
        {
            f32x16 zz;
#pragma unroll
            for (int i = 0; i < 16; ++i) zz[i] = 0.f;
            D0 = __builtin_amdgcn_mfma_f32_32x32x16_bf16(af, bfr[0], zz, 0, 0, 0);
            D1 = __builtin_amdgcn_mfma_f32_32x32x16_bf16(af, bfr[1], zz, 0, 0, 0);
            D2 = __builtin_amdgcn_mfma_f32_32x32x16_bf16(af, bfr[2], zz, 0, 0, 0);
            D3 = __builtin_amdgcn_mfma_f32_32x32x16_bf16(af, bfr[3], zz, 0, 0, 0);
        }
        if (MODE == 2) {
            const float* sre = P.in[2]; const float* sim = P.in[3];
            float* ore = P.out + O_RES; float* oim = P.out + O_IMS;
            float h0r[16], h0i[16], h1r[16], h1i[16];
#pragma unroll
            for (int s = 0; s < 16; ++s) {
                const size_t o = ((size_t)(b + s + 16 * h) * 32 + g) * 64 + c;
                h0r[s] = sre[o]; h0i[s] = sim[o]; h1r[s] = sre[o + 32]; h1i[s] = sim[o + 32];
            }
#pragma unroll
            for (int s = 0; s < 16; ++s) {
                const size_t o = ((size_t)(b + s + 16 * h) * 32 + g) * 64 + c;
                D0[s] += a0.x * h0r[s] - a0.y * h0i[s]; D2[s] += a0.x * h0i[s] + a0.y * h0r[s];
                D1[s] += a1.x * h1r[s] - a1.y * h1i[s]; D3[s] += a1.x * h1i[s] + a1.y * h1r[s];
                ore[o] = D0[s]; oim[o] = D2[s]; ore[o + 32] = D1[s]; oim[o + 32] = D3[s];
            }
        } else {
            float x0r = h ? 0.f : X0r, x0i = h ? 0.f : X0i, x1r = h ? 0.f : X1r, x1i = h ? 0.f : X1i;
#pragma unroll
            for (int s = 0; s < 16; ++s) {
                const float n0r = a0.x * x0r - a0.y * x0i + D0[s], n0i = a0.x * x0i + a0.y * x0r + D2[s];
                const float n1r = a1.x * x1r - a1.y * x1i + D1[s], n1i = a1.x * x1i + a1.y * x1r + D3[s];
                x0r = n0r; x0i = n0i; x1r = n1r; x1i = n1i;
                D0[s] = x0r; D2[s] = x0i; D1[s] = x1r; D3[s] = x1i;
            }
            const float y0r = __shfl(x0r, c), y0i = __shfl(x0i, c), y1r = __shfl(x1r, c), y1i = __shfl(x1i, c);
            if (MODE == 0) {
                const float2 q0 = tab_ab16[g * 64 + c], q1 = tab_ab16[g * 64 + c + 32];
                const float e0r = x0r + q0.x * y0r - q0.y * y0i, e0i = x0i + q0.x * y0i + q0.y * y0r;
                const float e1r = x1r + q1.x * y1r - q1.y * y1i, e1i = x1i + q1.x * y1i + q1.y * y1r;
                X0r = __shfl(e0r, c + 32); X0i = __shfl(e0i, c + 32); X1r = __shfl(e1r, c + 32); X1i = __shfl(e1i, c + 32);
            } else {
                float c0r = h ? y0r : 0.f, c0i = h ? y0i : 0.f, c1r = h ? y1r : 0.f, c1i = h ? y1i : 0.f;
#pragma unroll
                for (int s = 0; s < 16; ++s) {
                    const float n0r = a0.x * c0r - a0.y * c0i, n0i = a0.x * c0i + a0.y * c0r;
                    const float n1r = a1.x * c1r - a1.y * c1i, n1i = a1.x * c1i + a1.y * c1r;
                    c0r = n0r; c0i = n0i; c1r = n1r; c1i = n1i;
                    D0[s] += c0r; D2[s] += c0i; D1[s] += c1r; D3[s] += c1i;
                }
                X0r = __shfl(D0[15], c + 32); X0i = __shfl(D2[15], c + 32); X1r = __shfl(D1[15], c + 32); X1i = __shfl(D3[15], c + 32);
            }
        }
        if (MODE != 0) {
#pragma unroll
            for (int s = 0; s < 16; ++s) {
                u32x2 w; w.x = cvt_pk_bf16(D0[s], D2[s]); w.y = cvt_pk_bf16(D1[s], D3[s]);
                *(LAS u32x2*)(xs + (s + 16 * h) * XS_STRIDE + c * 8) = w;
            }
            LDS_WAIT();
            const int chn = lane & 15, q = lane >> 4;
#pragma unroll
            for (int tb = 0; tb < 2; ++tb) {
                f32x4 y = (f32x4){0.f, 0.f, 0.f, 0.f};
#pragma unroll
                for (int kk = 0; kk < 4; ++kk) {
                    const bf16x8 xa = *(const LAS bf16x8*)(xs + (tb * 16 + chn) * XS_STRIDE + kk * 64 + q * 16);
                    y = __builtin_amdgcn_mfma_f32_16x16x32_bf16(xa, cfr[kk], y, 0, 0, 0);
                }
#pragma unroll
                for (int r = 0; r < 4; ++r) {
                    const int row = rb + tb * 16 + 4 * q + r;
                    const float uv = bf2f(uraw[tb * 4 + r]);
                    const float zz = gelu_tanh(y[r] + dsk * uv);
                    zb[(size_t)row * SSMW + g * 16 + chn] = (bf16_t)(cvt_pk_bf16(zz, 0.f) & 0xffffu);
                }
            }
            LDS_WAIT();
        }
    }
    if (MODE == 0) {
        if (h == 0) { Eb[((size_t)(b * NCH + ch) * 32 + g) * 64 + c] = make_float2(X0r, X0i); Eb[((size_t)(b * NCH + ch) * 32 + g) * 64 + c + 32] = make_float2(X1r, X1i); }
    }
    if (MODE == 1) {
        if (ch == NCH - 1 && h == 0) {
            float* ore = P.out + O_REP; float* oim = P.out + O_IMP; const size_t o = ((size_t)b * 32 + g) * 64 + c;
            ore[o] = X0r; oim[o] = X0i; ore[o + 32] = X1r; oim[o + 32] = X1i;
        }
    }
}

template <int MODE>
__device__ __forceinline__ void ssm_pair_item(const Params& P, LAS unsigned char* xs, int lane, int item) {
    unsigned char* ws = P.ws;
    const bf16_t* pb = (const bf16_t*)(ws + WS_P);
    bf16_t* zb = (bf16_t*)(ws + WS_Z);
    const float2* tab_ab = (const float2*)(ws + WS_TAB + T_AB);
    const float2* tab_ab128 = (const float2*)(ws + WS_TAB + T_AB128);
    float2* Eb = (float2*)(ws + WS_E);
    const int c = lane & 31, h = lane >> 5;
    const int g = item & 31, ch = (item >> 5) % NCH, bp = item / (32 * NCH);
    const int bh = 2 * bp + h;
    const float2 a0 = tab_ab[g * 64 + c], a1 = tab_ab[g * 64 + c + 32];
    bf16x8 bfr[4];
#pragma unroll
    for (int nt = 0; nt < 4; ++nt) bfr[nt] = *(const bf16x8*)(ws + WS_TAB + T_BF + ((size_t)(g * 4 + nt) * 64 + lane) * 16);
    bf16x8 cfr[4];
    float dsk = 0.f;
    if (MODE != 0) {
#pragma unroll
        for (int kk = 0; kk < 4; ++kk) cfr[kk] = *(const bf16x8*)(ws + WS_TAB + T_CF + ((size_t)(g * 4 + kk) * 64 + lane) * 16);
        dsk = P.in[18][g * 16 + (lane & 15)];
    }
    float x0r = 0.f, x0i = 0.f, x1r = 0.f, x1i = 0.f;
    if (MODE == 1) {
        const float2 p0 = tab_ab128[g * 64 + c], p1 = tab_ab128[g * 64 + c + 32];
        const float2* e0p = Eb + ((size_t)(bh * NCH) * 32 + g) * 64 + c;
        for (int cc0 = 0; cc0 < ch; cc0 += 4) {
            float2 e0[4], e1[4];
#pragma unroll
            for (int q = 0; q < 4; ++q) { const int cc = (cc0 + q < ch) ? cc0 + q : ch - 1; e0[q] = e0p[(size_t)cc * 2048]; e1[q] = e0p[(size_t)cc * 2048 + 32]; }
#pragma unroll
            for (int q = 0; q < 4; ++q) if (cc0 + q < ch) {
                const float t0r = p0.x * x0r - p0.y * x0i + e0[q].x, t0i = p0.x * x0i + p0.y * x0r + e0[q].y; x0r = t0r; x0i = t0i;
                const float t1r = p1.x * x1r - p1.y * x1i + e1[q].x, t1i = p1.x * x1i + p1.y * x1r + e1[q].y; x1r = t1r; x1i = t1i;
            }
        }
    }
    const int tok = tau32(c);
    const int arow0 = (2 * bp + (tok >> 4)) * SEQ + ch * TCH + (tok & 15);
    constexpr int NSB = TCH / 16;
#pragma unroll 1
    for (int sq4 = 0; sq4 < NSB / 4; ++sq4) {
    bf16x8 afr[4];
#pragma unroll
    for (int s4 = 0; s4 < 4; ++s4) afr[s4] = *(const bf16x8*)(pb + (size_t)(arow0 + (sq4 * 4 + s4) * 16) * PW + g * 16 + 8 * h);
#pragma unroll
    for (int s4 = 0; s4 < 4; ++s4) {
        const int sb = sq4 * 4 + s4;
        const int rb0 = (2 * bp) * SEQ + ch * TCH + sb * 16;
        const bf16x8 af = afr[s4];
        unsigned short uraw[8];
        if (MODE != 0) {
#pragma unroll
            for (int tb = 0; tb < 2; ++tb)
#pragma unroll
                for (int r = 0; r < 4; ++r) uraw[tb * 4 + r] = pb[(size_t)(rb0 + tb * SEQ + 4 * (lane >> 4) + r) * PW + g * 16 + (lane & 15)];
        }
        f32x16 D0, D1, D2, D3;
        {
            f32x16 zz;
#pragma unroll
            for (int i = 0; i < 16; ++i) zz[i] = 0.f;
            D0 = __builtin_amdgcn_mfma_f32_32x32x16_bf16(af, bfr[0], zz, 0, 0, 0);
            D1 = __builtin_amdgcn_mfma_f32_32x32x16_bf16(af, bfr[1], zz, 0, 0, 0);
            D2 = __builtin_amdgcn_mfma_f32_32x32x16_bf16(af, bfr[2], zz, 0, 0, 0);
            D3 = __builtin_amdgcn_mfma_f32_32x32x16_bf16(af, bfr[3], zz, 0, 0, 0);
        }
#pragma unroll
        for (int s = 0; s < 16; ++s) {
            const float n0r = a0.x * x0r - a0.y * x0i + D0[s], n0i = a0.x * x0i + a0.y * x0r + D2[s];
            const float n1r = a1.x * x1r - a1.y * x1i + D1[s], n1i = a1.x * x1i + a1.y * x1r + D3[s];
            x0r = n0r; x0i = n0i; x1r = n1r; x1i = n1i;
            D0[s] = x0r; D2[s] = x0i; D1[s] = x1r; D3[s] = x1i;
        }
        if (MODE != 0) {
#pragma unroll
            for (int s = 0; s < 16; ++s) {
                u32x2 w; w.x = cvt_pk_bf16(D0[s], D2[s]); w.y = cvt_pk_bf16(D1[s], D3[s]);
                *(LAS u32x2*)(xs + (s + 16 * h) * XS_STRIDE + c * 8) = w;
            }
            LDS_WAIT();
            const int chn = lane & 15, q = lane >> 4;
#pragma unroll
            for (int tb = 0; tb < 2; ++tb) {
                f32x4 y = (f32x4){0.f, 0.f, 0.f, 0.f};
#pragma unroll
                for (int kk = 0; kk < 4; ++kk) {
                    const bf16x8 xa = *(const LAS bf16x8*)(xs + (tb * 16 + chn) * XS_STRIDE + kk * 64 + q * 16);
                    y = __builtin_amdgcn_mfma_f32_16x16x32_bf16(xa, cfr[kk], y, 0, 0, 0);
                }
#pragma unroll
                for (int r = 0; r < 4; ++r) {
                    const int row = rb0 + tb * SEQ + 4 * q + r;
                    const float uv = bf2f(uraw[tb * 4 + r]);
                    const float zz = gelu_tanh(y[r] + dsk * uv);
                    zb[(size_t)row * SSMW + g * 16 + chn] = (bf16_t)(cvt_pk_bf16(zz, 0.f) & 0xffffu);
                }
            }
            LDS_WAIT();
        }
        __builtin_amdgcn_sched_barrier(0);
    }
    }
    if (MODE == 0) {
        Eb[((size_t)(bh * NCH + ch) * 32 + g) * 64 + c] = make_float2(x0r, x0i); Eb[((size_t)(bh * NCH + ch) * 32 + g) * 64 + c + 32] = make_float2(x1r, x1i);
    }
    if (MODE == 1) {
        if (ch == NCH - 1) {
            float* ore = P.out + O_REP; float* oim = P.out + O_IMP; const size_t o = ((size_t)bh * 32 + g) * 64 + c;
            ore[o] = x0r; oim[o] = x0i; ore[o + 32] = x1r; oim[o + 32] = x1i;
        }
    }
}

__device__ __forceinline__ void conv_items(const Params& P, int it0, int it1, int stride) {
    unsigned char* ws = P.ws;
    const bf16_t* pbuf = (const bf16_t*)(ws + WS_P);
    bf16_t* mix = (bf16_t*)(ws + WS_MIX);
    const float* cw = P.in[21]; const float* scv = P.in[4];
        for (int it = it0; it < it1; it += stride) {
            const int row = it >> 6, c8 = (it & 63) * 8;
            const bf16_t* pr = pbuf + (size_t)row * PW;
            const u32x4 vc = *(const u32x4*)(pr + 1024 + c8), gb = *(const u32x4*)(pr + 512 + c8);
            float v0[8], v1[8], v2[8], gbf[8];
#pragma unroll
            for (int q = 0; q < 4; ++q) { v0[2 * q] = bflo(vc[q]); v0[2 * q + 1] = bfhi(vc[q]); gbf[2 * q] = bflo(gb[q]); gbf[2 * q + 1] = bfhi(gb[q]); }
            if (row < NPROMPT) {
                const int t = row & (SEQ - 1);
                if (t >= 1) { const u32x4 x1 = *(const u32x4*)(pr - PW + 1024 + c8);
#pragma unroll
                    for (int q = 0; q < 4; ++q) { v1[2 * q] = bflo(x1[q]); v1[2 * q + 1] = bfhi(x1[q]); } }
                else {
#pragma unroll
                    for (int q = 0; q < 8; ++q) v1[q] = 0.f; }
                if (t >= 2) { const u32x4 x2 = *(const u32x4*)(pr - 2 * PW + 1024 + c8);
#pragma unroll
                    for (int q = 0; q < 4; ++q) { v2[2 * q] = bflo(x2[q]); v2[2 * q + 1] = bfhi(x2[q]); } }
                else {
#pragma unroll
                    for (int q = 0; q < 8; ++q) v2[q] = 0.f; }
                if (t == SEQ - 1) { float* o = P.out + O_CVP + (size_t)(row >> 11) * 1024 + c8;
#pragma unroll
                    for (int q = 0; q < 8; ++q) { o[q] = v1[q]; o[512 + q] = v0[q]; } }
            } else {
                const int sb = row - NPROMPT; const float* bf = scv + (size_t)sb * 1024 + c8;
#pragma unroll
                for (int q = 0; q < 8; ++q) { v2[q] = bf[q]; v1[q] = bf[512 + q]; }
                float* o = P.out + O_CVS + (size_t)sb * 1024 + c8;
#pragma unroll
                for (int q = 0; q < 8; ++q) { o[q] = v1[q]; o[512 + q] = v0[q]; }
            }
            float co[8];
#pragma unroll
            for (int q = 0; q < 8; ++q) co[q] = gbf[q] * (cw[c8 + q] * v2[q] + cw[512 + c8 + q] * v1[q] + cw[1024 + c8 + q] * v0[q]);
            u32x4 w; w.x = pk2(co[0], co[1]); w.y = pk2(co[2], co[3]); w.z = pk2(co[4], co[5]); w.w = pk2(co[6], co[7]);
            *(u32x4*)(mix + (size_t)row * DM + 512 + c8) = w;
        }
}

typedef __attribute__((address_space(1))) unsigned gu32;
#define XB_TMO      128
#define XB_XCNT(j)  (256  + 64 * (j))
#define XB_XSUB(j)  (1280 + 64 * (j))
#define XB_XGEN(j)  (2304 + 64 * (j))
#define XB_TOP      3328
#define XB_TOPGEN   3392
#define XCD_BAR_WORDS 3456
#define XB_SPIN_CAP (1u << 18)

__device__ __forceinline__ unsigned xb_ld(unsigned* p)              { return __hip_atomic_load(p, __ATOMIC_RELAXED, __HIP_MEMORY_SCOPE_AGENT); }
__device__ __forceinline__ unsigned xb_add(unsigned* p, unsigned v) { return __hip_atomic_fetch_add(p, v, __ATOMIC_RELAXED, __HIP_MEMORY_SCOPE_AGENT); }
__device__ __forceinline__ unsigned xb_xcc_id() { return (unsigned)__builtin_amdgcn_s_getreg((3 << 11) | 20) & 0xFu; }
#define XB_SPIN(cond, bar) do { unsigned _sp = 0; while (cond) { __builtin_amdgcn_s_sleep(1); \
    if ((++_sp & 255u) == 0u) { if (xb_ld(&(bar)[XB_TMO])) break; if (_sp > XB_SPIN_CAP) { atomicAdd(&(bar)[XB_TMO], 1u); break; } } } } while (0)

struct XcdBarrier {
    unsigned* bar; unsigned x;
    volatile LAS unsigned* st;
};

__device__ __forceinline__ XcdBarrier xcd_barrier_post(unsigned* bar, volatile LAS unsigned* st) {
    XcdBarrier b; b.bar = bar; b.x = xb_xcc_id(); b.st = st;
    if (threadIdx.x == 0) (void)xb_add(&bar[XB_XCNT(b.x)], 1u);
    return b;
}
__device__ __forceinline__ void xcd_barrier_complete(unsigned* bar, unsigned x, unsigned& nloc, unsigned& nx) {
    const unsigned G = gridDim.x * gridDim.y * gridDim.z;
    unsigned sum, cnt, mine, sp = 0u;
    for (;;) {
        sum = 0u; cnt = 0u; mine = 0u;
#pragma unroll
        for (unsigned j = 0; j < 16; ++j) { const unsigned c = xb_ld(&bar[XB_XCNT(j)]); sum += c; cnt += (c > 0u) ? 1u : 0u; mine = (j == x) ? c : mine; }
        if (sum == G) break;
        __builtin_amdgcn_s_sleep(1);
        if ((++sp & 255u) == 0u) { if (xb_ld(&bar[XB_TMO])) break; if (sp > XB_SPIN_CAP) { atomicAdd(&bar[XB_TMO], 1u); break; } }
    }
    nloc = mine > 0u ? mine : 1u; nx = cnt > 0u ? cnt : 1u;
}

__device__ __forceinline__ void xcd_barrier(const XcdBarrier& b) {
    asm volatile("s_waitcnt vmcnt(0)" ::: "memory");
    __syncthreads();
    if (threadIdx.x == 0) {
        unsigned* bar = b.bar;
        __builtin_amdgcn_s_waitcnt(0);
        unsigned nloc = b.st[0], nx = b.st[1];
        if (nloc == 0u) { xcd_barrier_complete(bar, b.x, nloc, nx); b.st[0] = nloc; b.st[1] = nx; }
        const unsigned old = xb_add(&bar[XB_XSUB(b.x)], 1u);
        const unsigned gen = old / nloc;
        if (old + 1u == (gen + 1u) * nloc) {
            __builtin_amdgcn_fence(__ATOMIC_RELEASE, "agent");
            asm volatile("s_waitcnt vmcnt(0)" ::: "memory");
            const unsigned og = xb_add(&bar[XB_TOP], 1u);
            const unsigned tg = og / nx;
            if (og + 1u == (tg + 1u) * nx) xb_add(&bar[XB_TOPGEN], 1u);
            else XB_SPIN(xb_ld(&bar[XB_TOPGEN]) == tg, bar);
            __builtin_amdgcn_fence(__ATOMIC_ACQUIRE, "agent");
            xb_add(&bar[XB_XGEN(b.x)], 1u);
            asm volatile("s_waitcnt vmcnt(0)" ::: "memory");
        } else {
            XB_SPIN(xb_ld(&bar[XB_XGEN(b.x)]) == gen, bar);
            __builtin_amdgcn_fence(__ATOMIC_ACQUIRE, "agent");
            asm volatile("s_waitcnt vmcnt(0)" ::: "memory");
        }
    }
    __syncthreads();
}


__global__ void __launch_bounds__(NTHREADS, 2) hymba_fwd(Params P) {
    extern __shared__ __attribute__((aligned(16))) unsigned char lds_raw[];
    LAS unsigned char* lds = (LAS unsigned char*)lds_raw;
    cg::grid_group grid = cg::this_grid();
    const int tid = threadIdx.x, lane = tid & 63, wave = __builtin_amdgcn_readfirstlane(tid >> 6);
    const int G = gridDim.x, bid = blockIdx.x;
    const int gw = bid * NWAVES + wave, NGW = G * NWAVES;
    unsigned char* ws = P.ws;
    float* ss = (float*)(ws + WS_SS);
    bf16_t* ab = (bf16_t*)(ws + WS_AB);
    bf16_t* act = (bf16_t*)(ws + WS_ACT);
    bf16_t* pbuf = (bf16_t*)(ws + WS_P);
    bf16_t* zbuf = (bf16_t*)(ws + WS_Z);
    bf16_t* mix = (bf16_t*)(ws + WS_MIX);
    const float* xp = P.in[0]; const float* xsamp = P.in[1];
    volatile LAS unsigned* bst = (volatile LAS unsigned*)(lds + 131072 + 512);
    if (tid < 2) bst[tid] = 0u;
    __syncthreads();
    XcdBarrier xbar = xcd_barrier_post((unsigned*)(ws + WS_BAR), bst);

    {
        LAS float* scr = (LAS float*)(lds + wave * 16384);
        transpose_matrix<1>(P.in[6], DM, DFF, (bf16_t*)(ws + WS_WGU1), P.in[5], scr, lane, gw, NGW);
        transpose_matrix<2>(P.in[7], DM, DFF, (bf16_t*)(ws + WS_WGU1), P.in[5], scr, lane, gw, NGW);
        for (int row0 = gw; row0 < MROWS; row0 += 2 * NGW) {
            const int row1 = row0 + NGW; const bool has1 = row1 < MROWS; const int r1c = has1 ? row1 : row0;
            const float* xr0 = row0 < NPROMPT ? xp + (size_t)row0 * DM : xsamp + (size_t)(row0 - NPROMPT) * DM;
            const float* xr1 = r1c < NPROMPT ? xp + (size_t)r1c * DM : xsamp + (size_t)(r1c - NPROMPT) * DM;
            f32x4 v0[4], v1[4];
#pragma unroll
            for (int j = 0; j < 4; ++j) { v0[j] = *(const f32x4*)(xr0 + j * 256 + lane * 4); v1[j] = *(const f32x4*)(xr1 + j * 256 + lane * 4); }
            float s0 = 0.f, s1 = 0.f;
#pragma unroll
            for (int j = 0; j < 4; ++j) {
                s0 += (v0[j][0] * v0[j][0] + v0[j][1] * v0[j][1]) + (v0[j][2] * v0[j][2] + v0[j][3] * v0[j][3]);
                s1 += (v1[j][0] * v1[j][0] + v1[j][1] * v1[j][1]) + (v1[j][2] * v1[j][2] + v1[j][3] * v1[j][3]);
                u32x2 w; w.x = cvt_pk_bf16(v0[j][0], v0[j][1]); w.y = cvt_pk_bf16(v0[j][2], v0[j][3]);
                *(u32x2*)(ab + (size_t)row0 * DM + j * 256 + lane * 4) = w;
                if (has1) { u32x2 w1; w1.x = cvt_pk_bf16(v1[j][0], v1[j][1]); w1.y = cvt_pk_bf16(v1[j][2], v1[j][3]); *(u32x2*)(ab + (size_t)row1 * DM + j * 256 + lane * 4) = w1; }
            }
            s0 = wave_sum(s0); s1 = wave_sum(s1);
            if (lane == 0) { ss[row0] = s0; if (has1) ss[row1] = s1; }
        }
        for (int i = bid * NTHREADS + tid; i < 3 * MP; i += G * NTHREADS) ss[MP + i] = 0.f;
        for (int i = bid * NTHREADS + tid; i < MP - MROWS; i += G * NTHREADS) ss[MROWS + i] = 1024.f;
        if (bid == 0 && tid < 256) ((unsigned*)(ws + WS_CNT))[tid] = 0u;
        {
            float2* t_ab = (float2*)(ws + WS_TAB + T_AB); float2* t_ab16 = (float2*)(ws + WS_TAB + T_AB16); float2* t_ab128 = (float2*)(ws + WS_TAB + T_AB128);
            const float* lre = P.in[11]; const float* lim = P.in[12]; const float* ldt = P.in[13];
            for (int i = bid * NTHREADS + tid; i < NG * NS; i += G * NTHREADS) {
                const int g = i >> 6;
                const float dt = expf(ldt[g]); const float lr = lre[i], li = lim[i];
                const float mag = expf(lr * dt); const float th = li * dt;
                float ar = mag * cosf(th), ai = mag * sinf(th);
                t_ab[i] = make_float2(ar, ai);
                float pr = ar, pi = ai;
#pragma unroll
                for (int k = 0; k < 7; ++k) { const float nr = pr * pr - pi * pi, ni = 2.f * pr * pi; pr = nr; pi = ni; if (k == 3) t_ab16[i] = make_float2(pr, pi); }
                t_ab128[i] = make_float2(pr, pi);
            }
            bf16_t* t_bf = (bf16_t*)(ws + WS_TAB + T_BF); bf16_t* t_cf = (bf16_t*)(ws + WS_TAB + T_CF);
            const float* bre = P.in[14]; const float* bim = P.in[15]; const float* cre = P.in[16]; const float* cim = P.in[17];
            for (int i = bid * NTHREADS + tid; i < NG * 4 * 64 * 8; i += G * NTHREADS) {
                const int j = i & 7, ln = (i >> 3) & 63, nt = (i >> 9) & 3, g = i >> 11;
                {
                    const int st = (nt & 1) * 32 + (ln & 31), part = nt >> 1, chn = 8 * (ln >> 5) + j;
                    const int gi = g * 64 + st;
                    const float dt = expf(ldt[g]); const float lr = lre[gi], li = lim[gi];
                    const float mag = expf(lr * dt); const float th = li * dt;
                    const float ar = mag * cosf(th), ai = mag * sinf(th);
                    const float den = lr * lr + li * li, nr = ar - 1.0f, ni = ai;
                    const float cr = (nr * lr + ni * li) / den, ci = (ni * lr - nr * li) / den;
                    const float br = bre[(size_t)gi * 16 + chn], bi = bim[(size_t)gi * 16 + chn];
                    const float v = part == 0 ? (cr * br - ci * bi) : (cr * bi + ci * br);
                    t_bf[i] = (bf16_t)f2bf(v);
                }
                {
                    const int kk = nt, k = kk * 32 + 8 * (ln >> 4) + j, chn = ln & 15, cc = k >> 2, sel = k & 3;
                    const int st = cc + ((sel >> 1) ? 32 : 0);
                    const size_t ci_ = ((size_t)g * 16 + chn) * 64 + st;
                    const float v = (sel & 1) ? -cim[ci_] : cre[ci_];
                    t_cf[i] = (bf16_t)f2bf(v);
                }
            }
        }
    }
    if (gridDim.y == 7) grid.sync();
    xcd_barrier(xbar);

    {
        pg8::Gemm g{ab, (const bf16_t*)(ws + WS_WGU1), MP, 2 * DFF, DM}; pg8::SplitOrder S; S.init(2 * DFF, DM, 1, G, bid);
        EpiGateUp E{act, ss};
        pg8::gemm_phase<EpiGateUp, pg8::SplitOrder, true, true>(lds, g, S, E, pg8::SplitCtx{nullptr, nullptr, 1});
        const int first_idle = (65 * 22) % G;
        if (bid >= first_idle) {
            LAS float* scr = (LAS float*)(lds + wave * 16384);
            const int w2 = (bid - first_idle) * NWAVES + wave, NW2 = (G - first_idle) * NWAVES;
            transpose_matrix<0>(P.in[8], DFF, DM, (bf16_t*)(ws + WS_WD1), nullptr, scr, lane, w2, NW2);
            transpose_matrix<3>(P.in[10], DM, PW, (bf16_t*)(ws + WS_WIN), P.in[9], scr, lane, w2, NW2);
            transpose_matrix<0>(P.in[19], SSMW, SSMW, (bf16_t*)(ws + WS_WGLU), nullptr, scr, lane, w2, NW2);
            transpose_matrix<0>(P.in[22], DM, DM, (bf16_t*)(ws + WS_WOUT), nullptr, scr, lane, w2, NW2);
        }
    }
    xcd_barrier(xbar);
    {
        pg8::Gemm g{act, (const bf16_t*)(ws + WS_WD1), MP, DM, DFF}; pg8::SplitOrder S; S.init(DM, DFF, 22, G, bid);
        EpiResid<false> E{xp, xsamp, ab, ss + MP, 0.5f};
        pg8::gemm_phase<EpiResid<false>, pg8::SplitOrder, true, true>(lds, g, S, E, pg8::SplitCtx{(float*)(ws + WS_PART), (unsigned*)(ws + WS_CNT), 22});
        sample_finalize<true, true, 22>((const float*)(ws + WS_PART), (unsigned*)(ws + WS_CNT), 22, 88, xsamp, P.out, ab, ss + MP, 0.5f, bid, wave, lane, tid, lds);
    }
    xcd_barrier(xbar);
    {
        pg8::Gemm g{ab, (const bf16_t*)(ws + WS_WIN), MP, PW, DM}; pg8::SplitOrder S; S.init(PW, DM, 1, G, bid, 1);
        EpiInProj E{pbuf, ss + MP};
        pg8::gemm_phase<EpiInProj, pg8::SplitOrder, true, true>(lds, g, S, E, pg8::SplitCtx{nullptr, nullptr, 1});
    }
    xcd_barrier(xbar);
    if (bid < 8) {
        pg8::Gemm g{ab, (const bf16_t*)(ws + WS_WIN), MP, PW, DM}; pg8::SplitOrder S; S.init(PW, DM, 1, G, bid, 2);
        EpiInProj E{pbuf, ss + MP};
        pg8::gemm_phase<EpiInProj, pg8::SplitOrder, true, true>(lds, g, S, E, pg8::SplitCtx{nullptr, nullptr, 1});
    } else {
        LAS unsigned char* xs = lds + wave * XS_BYTES;
        const int gw4 = (bid - 8) * NWAVES + wave, NGW4 = (G - 8) * NWAVES;
        for (int it = gw4; it < NBATCH * NCH * 32; it += NGW4) { if (((it >> 5) % NCH) != NCH - 1) ssm_item<0>(P, xs, lane, it); }
        conv_items(P, (bid - 8) * NTHREADS + tid, NPROMPT * 64, (G - 8) * NTHREADS);
    }
    xcd_barrier(xbar);
    {
        LAS unsigned char* xs = lds + wave * XS_BYTES;
        for (int it = gw; it < (NBATCH / 2) * NCH * 32 + (NSAMP / 32) * 32; it += NGW) {
            if (it < (NBATCH / 2) * NCH * 32) ssm_pair_item<1>(P, xs, lane, it); else ssm_item<2>(P, xs, lane, it - (NBATCH / 2) * NCH * 32);
        }
        conv_items(P, NPROMPT * 64 + bid * NTHREADS + tid, MROWS * 64, G * NTHREADS);
    }
    xcd_barrier(xbar);
    {
        pg8::Gemm g{zbuf, (const bf16_t*)(ws + WS_WGLU), MP, SSMW, SSMW}; pg8::SplitOrder S; S.init(SSMW, SSMW, 1, G, bid);
        EpiGlu E{zbuf, P.in[20], mix};
        pg8::gemm_phase<EpiGlu, pg8::SplitOrder, true, true>(lds, g, S, E, pg8::SplitCtx{nullptr, nullptr, 1});
        const int first_idle = (65 * 2) % G;
        if (bid >= first_idle) {
            LAS float* scr = (LAS float*)(lds + wave * 16384);
            const int w2 = (bid - first_idle) * NWAVES + wave, NW2 = (G - first_idle) * NWAVES;
            transpose_matrix<1>(P.in[24], DM, DFF, (bf16_t*)(ws + WS_WGU2), P.in[23], scr, lane, w2, NW2);
            transpose_matrix<2>(P.in[25], DM, DFF, (bf16_t*)(ws + WS_WGU2), P.in[23], scr, lane, w2, NW2);
        }
    }
    xcd_barrier(xbar);
    {
        pg8::Gemm g{mix, (const bf16_t*)(ws + WS_WOUT), MP, DM, DM}; pg8::SplitOrder S; S.init(DM, DM, 8, G, bid);
        EpiResid<false> E{xp, xsamp, ab, ss + 2 * MP, 1.0f};
        pg8::gemm_phase<EpiResid<false>, pg8::SplitOrder, true, true>(lds, g, S, E, pg8::SplitCtx{(float*)(ws + WS_PART), (unsigned*)(ws + WS_CNT) + 160, 8});
        sample_finalize<true, true, 8>((const float*)(ws + WS_PART), (unsigned*)(ws + WS_CNT) + 160, 8, 32, xsamp, P.out, ab, ss + 2 * MP, 1.0f, bid, wave, lane, tid, lds);
    }
    xcd_barrier(xbar);
    {
        pg8::Gemm g{ab, (const bf16_t*)(ws + WS_WGU2), MP, 2 * DFF, DM}; pg8::SplitOrder S; S.init(2 * DFF, DM, 1, G, bid);
        EpiGateUp E{act, ss + 2 * MP};
        pg8::gemm_phase<EpiGateUp, pg8::SplitOrder, true, true>(lds, g, S, E, pg8::SplitCtx{nullptr, nullptr, 1});
        const int first_idle = (65 * 22) % G;
        if (bid >= first_idle) {
            LAS float* scr = (LAS float*)(lds + wave * 16384);
            const int w2 = (bid - first_idle) * NWAVES + wave, NW2 = (G - first_idle) * NWAVES;
            transpose_matrix<0>(P.in[26], DFF, DM, (bf16_t*)(ws + WS_WD2), nullptr, scr, lane, w2, NW2);
        }
    }
    xcd_barrier(xbar);
    {
        pg8::Gemm g{act, (const bf16_t*)(ws + WS_WD2), MP, DM, DFF}; pg8::SplitOrder S; S.init(DM, DFF, 22, G, bid);
        EpiFinal E{P.out, ab, ss + 3 * MP, (unsigned*)(ws + WS_CNT) + 64, P.in[27], 0.5f};
        pg8::gemm_phase<EpiFinal, pg8::SplitOrder, true, true>(lds, g, S, E, pg8::SplitCtx{(float*)(ws + WS_PART), (unsigned*)(ws + WS_CNT) + 32, 22});
        sample_finalize_norm<22>((const float*)(ws + WS_PART), (unsigned*)(ws + WS_CNT) + 32, 22, 88, P.out, ab, P.in[27], 0.5f, bid, wave, lane, tid, lds);
    }
}

extern "C" void kernel_launch(void* const* d_in, const int* in_sizes, int n_in, void* d_out, int out_size, void* d_ws, size_t ws_size, hipStream_t stream) {
    static int grid_blocks = 0;
    if (grid_blocks == 0) {
        if (n_in != 28 || ws_size < WS_END) { fprintf(stderr, "kernel_launch: unexpected n_in %d / ws %zu\n", n_in, ws_size); grid_blocks = -1; return; }
        int dev = 0, cus = 0, per_cu = 0;
        hipGetDevice(&dev);
        hipDeviceGetAttribute(&cus, hipDeviceAttributeMultiprocessorCount, dev);
        if (hipFuncSetAttribute((const void*)hymba_fwd, hipFuncAttributeMaxDynamicSharedMemorySize, LDS_BYTES) != hipSuccess) { fprintf(stderr, "kernel_launch: hipFuncSetAttribute failed\n"); grid_blocks = -1; return; }
        if (hipOccupancyMaxActiveBlocksPerMultiprocessor(&per_cu, (const void*)hymba_fwd, NTHREADS, LDS_BYTES) != hipSuccess || per_cu < 1) { fprintf(stderr, "kernel_launch: occupancy query gave %d\n", per_cu); per_cu = 1; }
        (void)hipGetLastError();
        grid_blocks = cus * 1;
        fprintf(stderr, "kernel_launch: cus %d per_cu %d grid %d\n", cus, per_cu, grid_blocks);
    }
    if (grid_blocks < 0) return;
    Params p{};
    for (int i = 0; i < 28; ++i) p.in[i] = (const float*)d_in[i];
    p.out = (float*)d_out; p.ws = (unsigned char*)d_ws;
    if (hipMemsetAsync((char*)d_ws + WS_BAR, 0, 16384, stream) != hipSuccess) { fprintf(stderr, "kernel_launch: memset failed\n"); return; }
    void* args[] = {&p};
    hipError_t e = hipLaunchCooperativeKernel((const void*)hymba_fwd, dim3(grid_blocks), dim3(NTHREADS), args, LDS_BYTES, stream);
    if (e != hipSuccess) fprintf(stderr, "cooperative launch failed: %s (grid %d)\n", hipGetErrorString(e), grid_blocks);
}
```

```cpp
#include <hip/hip_runtime.h>
#include <hip/hip_cooperative_groups.h>
#include <cstdio>
#include <cstdint>
namespace cg = cooperative_groups;

#define LAS __attribute__((address_space(3)))
typedef unsigned short bf16_t;
typedef short bf16x8 __attribute__((ext_vector_type(8)));
typedef float f32x4 __attribute__((ext_vector_type(4)));
typedef float f32x16 __attribute__((ext_vector_type(16)));
typedef unsigned u32x4 __attribute__((ext_vector_type(4)));
typedef unsigned u32x2 __attribute__((ext_vector_type(2)));

constexpr int DM = 1024, NPROMPT = 16384, NSAMP = 128, MROWS = NPROMPT + NSAMP, MP = 16640, DFF = 2816, SEQ = 2048, NBATCH = 8;
constexpr int NG = 32, NS = 64, PW = 2048, SSMW = 512;
constexpr int TCH = 128, NCH = SEQ / TCH;
constexpr float EPS = 1e-6f;
constexpr int NWAVES = 8, NTHREADS = 512;
constexpr int LDS_BYTES = 147456;

constexpr size_t O_REP = (size_t)MROWS * DM, O_IMP = O_REP + 16384, O_CVP = O_IMP + 16384, O_RES = O_CVP + 8192, O_IMS = O_RES + 262144, O_CVS = O_IMS + 262144;

constexpr size_t MiB = 1u << 20;
constexpr size_t WS_SS = 0;
constexpr size_t WS_TAB = 1 * MiB;
constexpr size_t T_AB = 0, T_AB16 = 16384, T_AB128 = 32768, T_BF = 49152, T_CF = T_BF + 131072;
constexpr size_t WS_WGU1 = 4 * MiB, WS_WD1 = WS_WGU1 + 11 * MiB, WS_WIN = WS_WD1 + 5632 * 1024, WS_WGLU = WS_WIN + 4 * MiB, WS_WOUT = WS_WGLU + 512 * 1024,
                 WS_WGU2 = WS_WOUT + 2 * MiB, WS_WD2 = WS_WGU2 + 11 * MiB;
constexpr size_t WS_AB = 44 * MiB;
constexpr size_t WS_ACT = 77 * MiB;
constexpr size_t WS_P = WS_ACT, WS_Z = WS_ACT + 65 * MiB;
constexpr size_t WS_MIX = 167 * MiB;
constexpr size_t WS_E = 200 * MiB;
constexpr size_t WS_PART = 202 * MiB;
constexpr size_t WS_BAR = 768 * 1024;
constexpr size_t WS_CNT = 512 * 1024;
constexpr size_t WS_END = 214 * MiB;

struct Params { const float* in[28]; float* out; unsigned char* ws; };

__device__ __forceinline__ unsigned f2bf(float f) { unsigned u = __builtin_bit_cast(unsigned, f); return (u + 0x7fffu + ((u >> 16) & 1u)) >> 16; }
__device__ __forceinline__ unsigned cvt_pk_bf16(float lo, float hi) { unsigned r; asm("v_cvt_pk_bf16_f32 %0, %1, %2" : "=v"(r) : "v"(lo), "v"(hi)); return r; }
__device__ __forceinline__ unsigned pk2(float lo, float hi) { return cvt_pk_bf16(lo, hi); }
__device__ __forceinline__ float bf2f(unsigned short b) { return __builtin_bit_cast(float, (unsigned)b << 16); }
__device__ __forceinline__ float bflo(unsigned w) { return __builtin_bit_cast(float, w << 16); }
__device__ __forceinline__ float bfhi(unsigned w) { return __builtin_bit_cast(float, w & 0xffff0000u); }
__device__ __forceinline__ float sigmoidf_(float x) { return __builtin_amdgcn_rcpf(1.0f + __builtin_amdgcn_exp2f(-1.4426950408889634f * x)); }
__device__ __forceinline__ float gelu_tanh(float y) { const float v = 0.7978845608028654f * (y + 0.044715f * y * y * y); return y * __builtin_amdgcn_rcpf(1.0f + __builtin_amdgcn_exp2f(-2.8853900817779268f * v)); }
__device__ __forceinline__ float wave_sum(float v) {
#pragma unroll
    for (int o = 1; o < 64; o <<= 1) v += __shfl_xor(v, o);
    return v;
}
#define LDS_WAIT() asm volatile("s_waitcnt lgkmcnt(0)" ::: "memory")

namespace pg8 {
constexpr int BM = 256, BK = 64, HALF = 128, HTB = HALF * BK * 2, STAGE_BYTES = 8 * HTB, NXCD = 8, WGM = 8;
__host__ __device__ __forceinline__ int lds_byte(int r, int c) { const int st = (r >> 4) * 2 + (c >> 5), rr = r & 15, cc = c & 31, ob = rr * 64 + cc * 2; return st * 1024 + (ob ^ (((ob >> 9) & 1) << 5)); }
__host__ __device__ __forceinline__ void stage_rc(int b, int& R, int& C) { const int st = b / 1024, sb = b % 1024, swz = sb ^ (((sb >> 9) & 1) << 5); R = (st >> 1) * 16 + swz / 64; C = (st & 1) * 32 + (swz % 64) / 2; }
__host__ __device__ __forceinline__ int perm32(int rho) { const int n = rho >> 4, i = rho & 15; return 8 * (i >> 2) + 4 * n + (i & 3); }
struct Unit { int pm, pn, k0, nt, split; };
struct Gemm { const bf16_t* A; const bf16_t* Bt; int M, N, K; };
struct SplitOrder {
    int nN, nwgp, nks, ntk, ntf, G, c, which;
    __device__ void init(int N, int K, int nks_, int G_, int c_, int which_ = 0) { nN = N / BM; nwgp = 64 * nN; nks = nks_; ntf = K / BK; ntk = ntf / nks_; G = G_; c = c_; which = which_; }
    __device__ bool next(int i, Unit& u) const {
        int L = i * G + c;
        if (which == 2) { if (L >= nN) return false; u.pm = 64; u.pn = L; u.k0 = 0; u.nt = ntf; u.split = -1; return true; }
        const int nsp = nks > 1 ? nN * nks : 0;
        if (L < nsp) { const int ks = L / nN; u.pm = 64; u.pn = L % nN; u.k0 = ks * ntk; u.nt = ntk; u.split = ks; return true; }
        L -= nsp;
        if (L < nwgp) {
            const int q = nwgp / NXCD, xcd = L % NXCD, off = L / NXCD; const int wgid = xcd * q + off;
            const int nig = WGM * nN, gid = wgid / nig, fm = gid * WGM;
            u.pm = fm + ((wgid % nig) % WGM); u.pn = (wgid % nig) / WGM; u.k0 = 0; u.nt = ntf; u.split = -1; return true;
        }
        if (nks > 1 || which == 1) return false;
        const int j = L - nwgp; if (j >= nN) return false;
        u.pm = 64; u.pn = j; u.k0 = 0; u.nt = ntf; u.split = -1; return true;
    }
};
struct SplitCtx { float* part; unsigned* cnt; int nks; };
template <class Epi, class Sched, bool ALIGN_EPI, bool SP2>
__device__ __forceinline__ void gemm_phase(LAS unsigned char* lds, const Gemm g, const Sched& S, const Epi& E, const SplitCtx sc) {
    int tid_ = threadIdx.x; asm volatile("" : "+v"(tid_));
    const int tid = tid_, wid = __builtin_amdgcn_readfirstlane(tid >> 6), lane = tid & 63, wr = wid >> 2, wc = wid & 3, fr = lane & 15, fq = lane >> 4;
    const int K = g.K;
    unsigned voffA[2], voffB[2];
#pragma unroll
    for (int i = 0; i < 2; ++i) { int R, C; stage_rc(tid * 16 + i * 8192, R, C); const int Rb = Epi::PERM ? ((R & ~31) + perm32(R & 31)) : R;
        voffA[i] = (unsigned)(R * K + C) * 2u; voffB[i] = (unsigned)(Rb * K + C) * 2u; }
    const size_t kstep = (size_t)(BK * 2);
    const size_t hstep = (size_t)HALF * K * 2;
    const size_t tstep = 2 * hstep;
    const unsigned ldsw = (unsigned)wid * 1024u;
    const int aoff = lds_byte(wr * 64 + fr, fq * 8), boff = lds_byte(wc * 32 + fr, fq * 8);
#define PG8_SA(b, h) (((b) * 2 + (h)) * HTB)
#define PG8_SB(b, h) ((4 + (b) * 2 + (h)) * HTB)
#define PG8_STAGE(bufoff, gbase, voff) do { _Pragma("unroll") for (int _i = 0; _i < 2; ++_i) \
        __builtin_amdgcn_global_load_lds((const unsigned*)((const char*)(gbase) + (voff)[_i]), (LAS unsigned*)(lds + (bufoff) + ldsw + _i * 8192), 16, 0, 0); } while (0)
#define PG8_LDA(dst, b, h) do { _Pragma("unroll") for (int m = 0; m < 4; ++m) _Pragma("unroll") for (int k = 0; k < 2; ++k) dst[m][k] = *(const LAS bf16x8*)(lds + PG8_SA(b, h) + aoff + m * 2048 + k * 1024); } while (0)
#define PG8_LDB(dst, b, h) do { _Pragma("unroll") for (int n = 0; n < 2; ++n) _Pragma("unroll") for (int k = 0; k < 2; ++k) dst[n][k] = *(const LAS bf16x8*)(lds + PG8_SB(b, h) + boff + n * 2048 + k * 1024); } while (0)
#define PG8_MMA(ai, bj, At, Bt) do { __builtin_amdgcn_s_setprio(1); _Pragma("unroll") for (int m = 0; m < 4; ++m) _Pragma("unroll") for (int n = 0; n < 2; ++n) _Pragma("unroll") for (int k = 0; k < 2; ++k) \
        acc[ai][bj][m][n] = __builtin_amdgcn_mfma_f32_16x16x32_bf16(Bt[n][k], At[m][k], acc[ai][bj][m][n], 0, 0, 0); __builtin_amdgcn_s_setprio(0); } while (0)
#define PG8_WAIT_V(n) asm volatile("s_waitcnt vmcnt(" #n ")" ::: "memory")
#define PG8_WAIT_L(n) asm volatile("s_waitcnt lgkmcnt(" #n ")" ::: "memory")
#define PG8_BAR __builtin_amdgcn_s_barrier()
#define PG8_SCHED __builtin_amdgcn_sched_barrier(0)
    Unit cur, nxt; int ui = 0;
    if (!S.next(0, cur)) return;
    f32x4 acc[2][2][4][2];
#pragma unroll
    for (int a = 0; a < 2; ++a)
#pragma unroll
        for (int b = 0; b < 2; ++b)
#pragma unroll
            for (int m = 0; m < 4; ++m)
#pragma unroll
                for (int n = 0; n < 2; ++n) acc[a][b][m][n] = (f32x4){0.f, 0.f, 0.f, 0.f};
    bf16x8 At[4][2], B0[2][2], B1[2][2];
    const char* cA = (const char*)g.A + (size_t)cur.pm * tstep + (size_t)cur.k0 * kstep; const char* cB = (const char*)g.Bt + (size_t)cur.pn * tstep + (size_t)cur.k0 * kstep;
    if constexpr (SP2) {
        PG8_STAGE(PG8_SB(0, 0), cB, voffB); PG8_STAGE(PG8_SB(0, 1), cB + hstep, voffB); PG8_STAGE(PG8_SA(0, 0), cA, voffA); PG8_STAGE(PG8_SA(0, 1), cA + hstep, voffA);
        if (wr == 1) PG8_BAR;
        PG8_WAIT_V(2); PG8_BAR;
        PG8_STAGE(PG8_SB(1, 0), cB + kstep, voffB); PG8_STAGE(PG8_SA(1, 0), cA + kstep, voffA); PG8_STAGE(PG8_SB(1, 1), cB + hstep + kstep, voffB);
        PG8_WAIT_V(6); PG8_BAR;
    } else {
        PG8_STAGE(PG8_SB(0, 0), cB, voffB); PG8_STAGE(PG8_SA(0, 0), cA, voffA); PG8_STAGE(PG8_SB(0, 1), cB + hstep, voffB); PG8_STAGE(PG8_SA(0, 1), cA + hstep, voffA);
        if (wr == 1) PG8_BAR;
        PG8_WAIT_V(4); PG8_BAR;
        PG8_STAGE(PG8_SB(1, 0), cB + kstep, voffB); PG8_STAGE(PG8_SA(1, 0), cA + kstep, voffA); PG8_STAGE(PG8_SB(1, 1), cB + hstep + kstep, voffB);
        PG8_WAIT_V(6); PG8_BAR;
    }
    for (;;) {
        const bool has_next = S.next(ui + 1, nxt);
        const char* nA = has_next ? (const char*)g.A + (size_t)nxt.pm * tstep + (size_t)nxt.k0 * kstep : cA; const char* nB = has_next ? (const char*)g.Bt + (size_t)nxt.pn * tstep + (size_t)nxt.k0 * kstep : cB;
        const int nt = cur.nt;
        for (int t = 0; t < nt; t += 2) {
            const bool last = (t == nt - 2);
            const char* a1 = cA + (size_t)(t + 1) * kstep;
            const char* a2 = last ? nA : cA + (size_t)(t + 2) * kstep; const char* b2 = last ? nB : cB + (size_t)(t + 2) * kstep;
            const char* a3 = a2 + kstep; const char* b3 = b2 + kstep;
            if constexpr (SP2) {
            PG8_LDB(B0, 0, 0); PG8_LDB(B1, 0, 1); PG8_SCHED; PG8_LDA(At, 0, 0); PG8_STAGE(PG8_SA(1, 1), a1 + hstep, voffA);
            PG8_WAIT_V(8); PG8_WAIT_L(0); PG8_BAR; PG8_MMA(0, 0, At, B0); PG8_MMA(0, 1, At, B1); PG8_BAR; PG8_SCHED;
            PG8_LDA(At, 0, 1); PG8_STAGE(PG8_SB(0, 0), b2, voffB); PG8_STAGE(PG8_SB(0, 1), b2 + hstep, voffB); PG8_STAGE(PG8_SA(0, 0), a2, voffA);
            PG8_WAIT_V(8); PG8_WAIT_L(0); PG8_BAR; PG8_MMA(1, 0, At, B0); PG8_MMA(1, 1, At, B1); PG8_BAR; PG8_SCHED;
            PG8_LDB(B0, 1, 0); PG8_LDB(B1, 1, 1); PG8_SCHED; PG8_LDA(At, 1, 0); PG8_STAGE(PG8_SA(0, 1), a2 + hstep, voffA);
            PG8_WAIT_V(8); PG8_WAIT_L(0); PG8_BAR; PG8_MMA(0, 0, At, B0); PG8_MMA(0, 1, At, B1); PG8_BAR; PG8_SCHED;
            PG8_LDA(At, 1, 1); PG8_STAGE(PG8_SB(1, 0), b3, voffB); PG8_STAGE(PG8_SB(1, 1), b3 + hstep, voffB); PG8_STAGE(PG8_SA(1, 0), a3, voffA);
            PG8_WAIT_V(8); PG8_WAIT_L(0); PG8_BAR; PG8_MMA(1, 0, At, B0); PG8_MMA(1, 1, At, B1); PG8_BAR; PG8_SCHED;
            } else {
            PG8_LDB(B0, 0, 0); PG8_SCHED; PG8_LDA(At, 0, 0); PG8_STAGE(PG8_SA(1, 1), a1 + hstep, voffA);
            PG8_WAIT_L(8); PG8_BAR; PG8_WAIT_L(0); PG8_MMA(0, 0, At, B0); PG8_BAR; PG8_SCHED;
            PG8_LDB(B1, 0, 1); PG8_STAGE(PG8_SB(0, 0), b2, voffB);
            PG8_BAR; PG8_WAIT_L(0); PG8_MMA(0, 1, At, B1); PG8_BAR;
            PG8_LDA(At, 0, 1); PG8_STAGE(PG8_SA(0, 0), a2, voffA);
            PG8_BAR; PG8_WAIT_L(0); PG8_MMA(1, 0, At, B0); PG8_BAR; PG8_SCHED;
            PG8_STAGE(PG8_SB(0, 1), b2 + hstep, voffB);
            PG8_WAIT_V(6); PG8_BAR; PG8_MMA(1, 1, At, B1); PG8_BAR;
            PG8_LDB(B0, 1, 0); PG8_SCHED; PG8_LDA(At, 1, 0); PG8_STAGE(PG8_SA(0, 1), a2 + hstep, voffA);
            PG8_WAIT_L(8); PG8_BAR; PG8_WAIT_L(0); PG8_MMA(0, 0, At, B0); PG8_BAR; PG8_SCHED;
            PG8_LDB(B1, 1, 1); PG8_STAGE(PG8_SB(1, 0), b3, voffB);
            PG8_BAR; PG8_WAIT_L(0); PG8_MMA(0, 1, At, B1); PG8_BAR;
            PG8_LDA(At, 1, 1); PG8_STAGE(PG8_SA(1, 0), a3, voffA);
            PG8_BAR; PG8_WAIT_L(0); PG8_MMA(1, 0, At, B0); PG8_BAR; PG8_SCHED;
            PG8_STAGE(PG8_SB(1, 1), b3 + hstep, voffB);
            PG8_WAIT_V(6); PG8_BAR; PG8_MMA(1, 1, At, B1); PG8_BAR;
            }
        }
        if constexpr (ALIGN_EPI) { if (wr == 0) PG8_BAR; }
        if (cur.split < 0) E(acc, cur, wr, wc, fr, fq);
        else {
            float* slab = sc.part + (size_t)cur.split * (128 * g.N) + cur.pn * 256;
#pragma unroll
            for (int m = 0; m < 4; ++m)
#pragma unroll
                for (int bj = 0; bj < 2; ++bj)
#pragma unroll
                    for (int n = 0; n < 2; ++n) *(f32x4*)(slab + (size_t)(wr * 64 + m * 16 + fr) * g.N + bj * 128 + wc * 32 + (Epi::PERM ? 8 * fq + 4 * n : n * 16 + 4 * fq)) = acc[0][bj][m][n];
            asm volatile("s_waitcnt vmcnt(0) lgkmcnt(0)" ::: "memory"); __builtin_amdgcn_s_barrier(); asm volatile("" ::: "memory");
            if (tid == 0) {
                __builtin_amdgcn_fence(__ATOMIC_RELEASE, "agent");
                asm volatile("s_waitcnt vmcnt(0)" ::: "memory");
                __hip_atomic_fetch_add(sc.cnt, 1u, __ATOMIC_RELAXED, __HIP_MEMORY_SCOPE_AGENT);
            }
        }
        if (!has_next) break;
#pragma unroll
        for (int a = 0; a < 2; ++a)
#pragma unroll
            for (int b = 0; b < 2; ++b)
#pragma unroll
                for (int m = 0; m < 4; ++m)
#pragma unroll
                    for (int n = 0; n < 2; ++n) acc[a][b][m][n] = (f32x4){0.f, 0.f, 0.f, 0.f};
        cur = nxt; cA = nA; cB = nB; ++ui;
        if constexpr (ALIGN_EPI) { if (wr == 1) PG8_BAR; }
    }
    PG8_WAIT_V(0);
    if constexpr (!ALIGN_EPI) { if (wr == 0) PG8_BAR; }
    PG8_BAR;
#undef PG8_SA
#undef PG8_SB
#undef PG8_STAGE
#undef PG8_LDA
#undef PG8_LDB
#undef PG8_MMA
#undef PG8_WAIT_V
#undef PG8_WAIT_L
#undef PG8_BAR
#undef PG8_SCHED
}
}

struct EpiGateUp {
    static constexpr bool PERM = true;
    bf16_t* act; const float* ss;
    __device__ __forceinline__ void operator()(const f32x4 (&acc)[2][2][4][2], const pg8::Unit& u, int wr, int wc, int fr, int fq) const {
        float ssv[2][4];
#pragma unroll
        for (int ai = 0; ai < 2; ++ai)
#pragma unroll
            for (int m = 0; m < 4; ++m) ssv[ai][m] = ss[u.pm * 256 + ai * 128 + wr * 64 + m * 16 + fr];
#pragma unroll
        for (int ai = 0; ai < 2; ++ai)
#pragma unroll
            for (int m = 0; m < 4; ++m) {
                const int row = u.pm * 256 + ai * 128 + wr * 64 + m * 16 + fr;
                const float rs = __builtin_amdgcn_rsqf(ssv[ai][m] * (1.0f / DM) + EPS);
                float v[8];
#pragma unroll
                for (int n = 0; n < 2; ++n)
#pragma unroll
                    for (int i = 0; i < 4; ++i) { const float gt = acc[ai][0][m][n][i] * rs, up = acc[ai][1][m][n][i] * rs; v[n * 4 + i] = gt * sigmoidf_(gt) * up; }
                u32x4 w; w.x = pk2(v[0], v[1]); w.y = pk2(v[2], v[3]); w.z = pk2(v[4], v[5]); w.w = pk2(v[6], v[7]);
                *(u32x4*)(act + (size_t)row * DFF + u.pn * 128 + wc * 32 + 8 * fq) = w;
            }
    }
};
template <bool BASE_X> struct EpiResid {
    static constexpr bool PERM = true;
    const float* xp; const float* xs; bf16_t* hb; float* ssn; float scale;
    __device__ __forceinline__ void operator()(const f32x4 (&acc)[2][2][4][2], const pg8::Unit& u, int wr, int wc, int fr, int fq) const {
#pragma unroll
        for (int ai = 0; ai < 2; ++ai) {
            u32x2 hw[4][2][2];
#pragma unroll
            for (int m = 0; m < 4; ++m) {
                const int row = u.pm * 256 + ai * 128 + wr * 64 + m * 16 + fr;
#pragma unroll
                for (int bj = 0; bj < 2; ++bj)
#pragma unroll
                    for (int n = 0; n < 2; ++n) hw[m][bj][n] = *(const u32x2*)(hb + (size_t)row * DM + u.pn * 256 + bj * 128 + wc * 32 + 8 * fq + 4 * n);
            }
#pragma unroll
            for (int m = 0; m < 4; ++m) {
                const int row = u.pm * 256 + ai * 128 + wr * 64 + m * 16 + fr;
                float sq = 0.f;
#pragma unroll
                for (int bj = 0; bj < 2; ++bj)
#pragma unroll
                    for (int n = 0; n < 2; ++n) {
                        const int col = u.pn * 256 + bj * 128 + wc * 32 + 8 * fq + 4 * n;
                        const u32x2 h2 = hw[m][bj][n];
                        const f32x4 hv = (f32x4){bflo(h2.x), bfhi(h2.x), bflo(h2.y), bfhi(h2.y)} + acc[ai][bj][m][n] * scale;
                        u32x2 w; w.x = pk2(hv[0], hv[1]); w.y = pk2(hv[2], hv[3]);
                        *(u32x2*)(hb + (size_t)row * DM + col) = w;
                        sq += (hv[0] * hv[0] + hv[1] * hv[1]) + (hv[2] * hv[2] + hv[3] * hv[3]);
                    }
                sq += __shfl_xor(sq, 16); sq += __shfl_xor(sq, 32);
                if (fq == 0) atomicAdd(ssn + row, sq);
            }
        }
    }
};
struct EpiFinal {
    static constexpr bool PERM = true;
    float* out; const bf16_t* hb; float* ssn; unsigned* pcnt; const float* gamma; float scale;
    __device__ __forceinline__ void operator()(f32x4 (&acc)[2][2][4][2], const pg8::Unit& u, int wr, int wc, int fr, int fq) const {
#pragma unroll
        for (int ai = 0; ai < 2; ++ai) {
            u32x2 hwv[4][2][2];
#pragma unroll
            for (int m = 0; m < 4; ++m) {
                const int row = u.pm * 256 + ai * 128 + wr * 64 + m * 16 + fr;
#pragma unroll
                for (int bj = 0; bj < 2; ++bj)
#pragma unroll
                    for (int n = 0; n < 2; ++n) hwv[m][bj][n] = *(const u32x2*)(hb + (size_t)row * DM + u.pn * 256 + bj * 128 + wc * 32 + 8 * fq + 4 * n);
            }
#pragma unroll
            for (int m = 0; m < 4; ++m) {
                const int row = u.pm * 256 + ai * 128 + wr * 64 + m * 16 + fr;
                float sq = 0.f;
#pragma unroll
                for (int bj = 0; bj < 2; ++bj)
#pragma unroll
                    for (int n = 0; n < 2; ++n) {
                        const u32x2 hw = hwv[m][bj][n];
                        const f32x4 hv = (f32x4){bflo(hw.x), bfhi(hw.x), bflo(hw.y), bfhi(hw.y)} + acc[ai][bj][m][n] * scale;
                        acc[ai][bj][m][n] = hv;
                        sq += (hv[0] * hv[0] + hv[1] * hv[1]) + (hv[2] * hv[2] + hv[3] * hv[3]);
                    }
                sq += __shfl_xor(sq, 16); sq += __shfl_xor(sq, 32);
                if (fq == 0) atomicAdd(ssn + row, sq);
            }
        }
        asm volatile("s_waitcnt vmcnt(0) lgkmcnt(0)" ::: "memory"); __builtin_amdgcn_s_barrier(); asm volatile("" ::: "memory");
        if (wr == 0 && wc == 0 && fr == 0 && fq == 0) {
            __builtin_amdgcn_fence(__ATOMIC_RELEASE, "agent");
            asm volatile("s_waitcnt vmcnt(0)" ::: "memory");
            __hip_atomic_fetch_add(pcnt + u.pm, 1u, __ATOMIC_RELAXED, __HIP_MEMORY_SCOPE_AGENT);
            unsigned sp = 0;
            while (__hip_atomic_load(pcnt + u.pm, __ATOMIC_RELAXED, __HIP_MEMORY_SCOPE_AGENT) < 4u) { __builtin_amdgcn_s_sleep(1); if (++sp > (1u << 22)) break; }
            __builtin_amdgcn_fence(__ATOMIC_ACQUIRE, "agent");
            asm volatile("s_waitcnt vmcnt(0)" ::: "memory");
        }
        asm volatile("s_waitcnt vmcnt(0) lgkmcnt(0)" ::: "memory"); __builtin_amdgcn_s_barrier(); asm volatile("" ::: "memory");
        float sv[2][4]; f32x4 gnv[2][2];
#pragma unroll
        for (int ai = 0; ai < 2; ++ai)
#pragma unroll
            for (int m = 0; m < 4; ++m) sv[ai][m] = __hip_atomic_load(ssn + u.pm * 256 + ai * 128 + wr * 64 + m * 16 + fr, __ATOMIC_RELAXED, __HIP_MEMORY_SCOPE_AGENT);
#pragma unroll
        for (int bj = 0; bj < 2; ++bj)
#pragma unroll
            for (int n = 0; n < 2; ++n) gnv[bj][n] = *(const f32x4*)(gamma + u.pn * 256 + bj * 128 + wc * 32 + 8 * fq + 4 * n);
#pragma unroll
        for (int ai = 0; ai < 2; ++ai)
#pragma unroll
            for (int m = 0; m < 4; ++m) {
                const int row = u.pm * 256 + ai * 128 + wr * 64 + m * 16 + fr;
                const float rs = __builtin_amdgcn_rsqf(sv[ai][m] * (1.0f / DM) + EPS);
#pragma unroll
                for (int bj = 0; bj < 2; ++bj)
#pragma unroll
                    for (int n = 0; n < 2; ++n) {
                        const int col = u.pn * 256 + bj * 128 + wc * 32 + 8 * fq + 4 * n;
                        *(f32x4*)(out + (size_t)row * DM + col) = acc[ai][bj][m][n] * rs * gnv[bj][n];
                    }
            }
    }
};
struct EpiInProj {
    static constexpr bool PERM = true;
    bf16_t* p; const float* ss;
    __device__ __forceinline__ void operator()(const f32x4 (&acc)[2][2][4][2], const pg8::Unit& u, int wr, int wc, int fr_, int fq_) const {
        int fr = fr_, fq = fq_; asm volatile("" : "+v"(fr), "+v"(fq));
#pragma unroll
        for (int ai = 0; ai < 2; ++ai)
#pragma unroll
            for (int m = 0; m < 4; ++m) {
                const int row = u.pm * 256 + ai * 128 + wr * 64 + m * 16 + fr;
                const float rs = __builtin_amdgcn_rsqf(ss[row] * (1.0f / DM) + EPS);
                if (u.pn < 4) {
#pragma unroll
                    for (int bj = 0; bj < 2; ++bj) {
                        const f32x4 a = acc[ai][bj][m][0] * rs, b = acc[ai][bj][m][1] * rs;
                        u32x4 w; w.x = pk2(a[0], a[1]); w.y = pk2(a[2], a[3]); w.z = pk2(b[0], b[1]); w.w = pk2(b[2], b[3]);
                        *(u32x4*)(p + (size_t)row * PW + u.pn * 256 + bj * 128 + wc * 32 + 8 * fq) = w;
                    }
                } else {
                    const float r2 = rs * rs;
                    const f32x4 a = acc[ai][0][m][0] * acc[ai][1][m][0] * r2, b = acc[ai][0][m][1] * acc[ai][1][m][1] * r2;
                    u32x4 w; w.x = pk2(a[0], a[1]); w.y = pk2(a[2], a[3]); w.z = pk2(b[0], b[1]); w.w = pk2(b[2], b[3]);
                    *(u32x4*)(p + (size_t)row * PW + 1024 + (u.pn - 4) * 128 + wc * 32 + 8 * fq) = w;
                }
            }
    }
};
struct EpiGlu {
    static constexpr bool PERM = true;
    const bf16_t* z; const float* bias; bf16_t* mix;
    __device__ __forceinline__ void operator()(const f32x4 (&acc)[2][2][4][2], const pg8::Unit& u, int wr, int wc, int fr, int fq) const {
#pragma unroll
        for (int bj = 0; bj < 2; ++bj) {
            const int col = u.pn * 256 + bj * 128 + wc * 32 + 8 * fq;
            const f32x4 b0 = *(const f32x4*)(bias + col), b1 = *(const f32x4*)(bias + col + 4);
            u32x4 zv[2][4];
#pragma unroll
            for (int ai = 0; ai < 2; ++ai)
#pragma unroll
                for (int m = 0; m < 4; ++m) zv[ai][m] = *(const u32x4*)(z + (size_t)(u.pm * 256 + ai * 128 + wr * 64 + m * 16 + fr) * SSMW + col);
#pragma unroll
            for (int ai = 0; ai < 2; ++ai)
#pragma unroll
                for (int m = 0; m < 4; ++m) {
                    const int row = u.pm * 256 + ai * 128 + wr * 64 + m * 16 + fr;
                    const u32x4 zz = zv[ai][m];
                    const f32x4 a = acc[ai][bj][m][0] + b0, b = acc[ai][bj][m][1] + b1;
                    u32x4 w;
                    w.x = pk2(bflo(zz.x) * sigmoidf_(a[0]), bfhi(zz.x) * sigmoidf_(a[1]));
                    w.y = pk2(bflo(zz.y) * sigmoidf_(a[2]), bfhi(zz.y) * sigmoidf_(a[3]));
                    w.z = pk2(bflo(zz.z) * sigmoidf_(b[0]), bfhi(zz.z) * sigmoidf_(b[1]));
                    w.w = pk2(bflo(zz.w) * sigmoidf_(b[2]), bfhi(zz.w) * sigmoidf_(b[3]));
                    *(u32x4*)(mix + (size_t)row * DM + col) = w;
                }
        }
    }
};

template <bool BASE_X, bool WRITE_HB, int NKS>
__device__ __forceinline__ void sample_finalize(const float* part, unsigned* cnt, int nks, int nsplit_units, const float* xs, float* out, bf16_t* hb, float* ssn, float scale,
                                                int bid, int wave, int lane, int tid, LAS unsigned char* lds) {
    if (bid >= 128) return;
    if (tid == 0) {
        unsigned sp = 0;
        while (__hip_atomic_load(cnt, __ATOMIC_RELAXED, __HIP_MEMORY_SCOPE_AGENT) < (unsigned)nsplit_units) { __builtin_amdgcn_s_sleep(2); if (++sp > (1u << 22)) break; }
        __builtin_amdgcn_fence(__ATOMIC_ACQUIRE, "agent");
        asm volatile("s_waitcnt vmcnt(0)" ::: "memory");
    }
    __syncthreads();
    if (wave < 4) {
        const int r = bid, col = wave * 256 + lane * 4, row = NPROMPT + r;
        f32x4 pv[NKS];
#pragma unroll
        for (int ks = 0; ks < NKS; ++ks) pv[ks] = *(const f32x4*)(part + ((size_t)ks * 128 + r) * DM + col);
        f32x4 s = (f32x4){0.f, 0.f, 0.f, 0.f};
#pragma unroll
        for (int ks = 0; ks < NKS; ++ks) s += pv[ks];
        f32x4 hv; { const u32x2 hw = *(const u32x2*)(hb + (size_t)row * DM + col); hv = (f32x4){bflo(hw.x), bfhi(hw.x), bflo(hw.y), bfhi(hw.y)} + s * scale; }
        if (WRITE_HB) { u32x2 w; w.x = pk2(hv[0], hv[1]); w.y = pk2(hv[2], hv[3]); *(u32x2*)(hb + (size_t)row * DM + col) = w; }
        float sq = (hv[0] * hv[0] + hv[1] * hv[1]) + (hv[2] * hv[2] + hv[3] * hv[3]);
        sq = wave_sum(sq);
        if (lane == 0) atomicAdd(ssn + row, sq);
    }
}

template <int NKS>
__device__ __forceinline__ void sample_finalize_norm(const float* part, unsigned* cnt, int nks, int nsplit_units, float* out, const bf16_t* hb, const float* gamma, float scale,
                                                     int bid, int wave, int lane, int tid, LAS unsigned char* lds) {
    if (bid >= 128) return;
    if (tid == 0) {
        unsigned sp = 0;
        while (__hip_atomic_load(cnt, __ATOMIC_RELAXED, __HIP_MEMORY_SCOPE_AGENT) < (unsigned)nsplit_units) { __builtin_amdgcn_s_sleep(2); if (++sp > (1u << 22)) break; }
        __builtin_amdgcn_fence(__ATOMIC_ACQUIRE, "agent");
        asm volatile("s_waitcnt vmcnt(0)" ::: "memory");
    }
    __syncthreads();
    LAS float* red = (LAS float*)(lds + 131072 + 1024);
    const int r = bid, col = (wave & 3) * 256 + lane * 4, row = NPROMPT + r;
    f32x4 hv = (f32x4){0.f, 0.f, 0.f, 0.f};
    if (wave < 4) {
        f32x4 pv[NKS];
#pragma unroll
        for (int ks = 0; ks < NKS; ++ks) pv[ks] = *(const f32x4*)(part + ((size_t)ks * 128 + r) * DM + col);
        f32x4 s = (f32x4){0.f, 0.f, 0.f, 0.f};
#pragma unroll
        for (int ks = 0; ks < NKS; ++ks) s += pv[ks];
        { const u32x2 hw = *(const u32x2*)(hb + (size_t)row * DM + col); hv = (f32x4){bflo(hw.x), bfhi(hw.x), bflo(hw.y), bfhi(hw.y)} + s * scale; }
        float sq = (hv[0] * hv[0] + hv[1] * hv[1]) + (hv[2] * hv[2] + hv[3] * hv[3]);
        sq = wave_sum(sq);
        if (lane == 0) red[wave] = sq;
    }
    __syncthreads();
    if (wave < 4) {
        const float tot = (red[0] + red[1]) + (red[2] + red[3]);
        const float rs = __builtin_amdgcn_rsqf(tot * (1.0f / DM) + EPS);
        const f32x4 gn = *(const f32x4*)(gamma + col);
        *(f32x4*)(out + (size_t)row * DM + col) = hv * rs * gn;
    }
}

__device__ __forceinline__ void transpose_item(const float* W, int N, int k0, int n0, bf16_t* WT, int K, int drow0, const float* gain, LAS float* scr, int lane) {
    float wv[32];
    const float* wp = W + (size_t)(k0 + (lane >> 5)) * N + n0 + (lane & 31);
#pragma unroll
    for (int i = 0; i < 32; ++i) wv[i] = wp[(size_t)(2 * i) * N];
    const float gsc = gain ? gain[k0 + lane] : 1.0f;
#pragma unroll
    for (int i = 0; i < 32; ++i) { const int kk = 2 * i + (lane >> 5); scr[kk * 33 + (lane & 31)] = wv[i] * __shfl(gsc, kk); }
    LDS_WAIT();
    const int c = lane & 7;
#pragma unroll
    for (int j = 0; j < 4; ++j) { const int n = (lane >> 3) + 8 * j; const LAS float* s = scr + (8 * c) * 33 + n;
        u32x4 o; o.x = pk2(s[0 * 33], s[1 * 33]); o.y = pk2(s[2 * 33], s[3 * 33]); o.z = pk2(s[4 * 33], s[5 * 33]); o.w = pk2(s[6 * 33], s[7 * 33]);
        *(u32x4*)(WT + (size_t)(drow0 + n) * K + k0 + 8 * c) = o; }
    LDS_WAIT();
}
template <int GU>
__device__ __forceinline__ void transpose_matrix(const float* W, int K, int N, bf16_t* WT, const float* gain, LAS float* scr, int lane, int gw, int NGW) {
    const int nblk = N / 32, nitems = (K / 64) * nblk;
    for (int it = gw; it < nitems; it += NGW) {
        const int kb = it / nblk, nb = it % nblk, n0 = nb * 32;
        int drow0;
        if (GU == 0) drow0 = n0;
        else if (GU == 3) {
            const int seg = n0 >> 9, j = n0 & 511;
            drow0 = seg == 0 ? j : seg == 2 ? 512 + j : (4 + (j >> 7)) * 256 + (j & 127) + (seg == 3 ? 128 : 0);
        } else drow0 = 256 * (n0 / 128) + (n0 % 128) + (GU == 2 ? 128 : 0);
        transpose_item(W, N, kb * 64, n0, WT, K, drow0, gain, scr, lane);
    }
}

__device__ __forceinline__ int tau32(int r) { return (r & 3) + 4 * (r >> 3) + 16 * ((r >> 2) & 1); }
constexpr int XS_STRIDE = 272, XS_BYTES = 32 * XS_STRIDE;

template <int MODE>
__device__ __forceinline__ void ssm_item(const Params& P, LAS unsigned char* xs, int lane, int item) {
    unsigned char* ws = P.ws;
    const bf16_t* pb = (const bf16_t*)(ws + WS_P);
    bf16_t* zb = (bf16_t*)(ws + WS_Z);
    const float2* tab_ab = (const float2*)(ws + WS_TAB + T_AB);
    const float2* tab_ab16 = (const float2*)(ws + WS_TAB + T_AB16);
    const float2* tab_ab128 = (const float2*)(ws + WS_TAB + T_AB128);
    float2* Eb = (float2*)(ws + WS_E);
    const int c = lane & 31, h = lane >> 5;
    int g, b = 0, ch = 0, row0, nblk;
    if (MODE == 2) { g = item & 31; const int sb = item >> 5; row0 = NPROMPT + sb * 32; nblk = 1; b = sb * 32; }
    else { g = item & 31; ch = (item >> 5) % NCH; b = item / (32 * NCH); row0 = b * SEQ + ch * TCH; nblk = TCH / 32; }
    const float2 a0 = tab_ab[g * 64 + c], a1 = tab_ab[g * 64 + c + 32];
    bf16x8 bfr[4];
#pragma unroll
    for (int nt = 0; nt < 4; ++nt) bfr[nt] = *(const bf16x8*)(ws + WS_TAB + T_BF + ((size_t)(g * 4 + nt) * 64 + lane) * 16);
    bf16x8 cfr[4];
    f32x4 dsk4 = (f32x4){0.f, 0.f, 0.f, 0.f};
    if (MODE != 0) {
#pragma unroll
        for (int kk = 0; kk < 4; ++kk) cfr[kk] = *(const bf16x8*)(ws + WS_TAB + T_CF + ((size_t)(g * 4 + kk) * 64 + lane) * 16);
        dsk4 = *(const f32x4*)(P.in[18] + g * 16 + 4 * (lane >> 4));
    }
    float X0r = 0.f, X0i = 0.f, X1r = 0.f, X1i = 0.f;
    if (MODE == 1) {
        const float2 p0 = tab_ab128[g * 64 + c], p1 = tab_ab128[g * 64 + c + 32];
        const float2* e0p = Eb + ((size_t)(b * NCH) * 32 + g) * 64 + c;
        for (int cc0 = 0; cc0 < ch; cc0 += 4) {
            float2 e0[4], e1[4];
#pragma unroll
            for (int q = 0; q < 4; ++q) { const int cc = (cc0 + q < ch) ? cc0 + q : ch - 1; e0[q] = e0p[(size_t)cc * 2048]; e1[q] = e0p[(size_t)cc * 2048 + 32]; }
#pragma unroll
            for (int q = 0; q < 4; ++q) if (cc0 + q < ch) {
                const float t0r = p0.x * X0r - p0.y * X0i + e0[q].x, t0i = p0.x * X0i + p0.y * X0r + e0[q].y; X0r = t0r; X0i = t0i;
                const float t1r = p1.x * X1r - p1.y * X1i + e1[q].x, t1i = p1.x * X1i + p1.y * X1r + e1[q].y; X1r = t1r; X1i = t1i;
            }
        }
    }
    const int tok = tau32(c);
    constexpr int NBLK = (MODE == 2) ? 1 : TCH / 32;
    bf16x8 afr[NBLK];
#pragma unroll
    for (int blk = 0; blk < NBLK; ++blk) afr[blk] = *(const bf16x8*)(pb + (size_t)(row0 + blk * 32 + tok) * PW + g * 16 + 8 * h);
#pragma unroll
    for (int blk = 0; blk < NBLK; ++blk) {
        const int rb = row0 + blk * 32;
        const bf16x8 af = afr[blk];
        u32x2 uraw[2];
        if (MODE != 0) {
#pragma unroll
            for (int tb = 0; tb < 2; ++tb) uraw[tb] = *(const u32x2*)(pb + (size_t)(rb + tb * 16 + (lane & 15)) * PW + g * 16 + 4 * (lane >> 4));
        }
        f32x16 D0, D1, D2, D3;
        {
            f32x16 zz;
#pragma unroll
            for (int i = 0; i < 16; ++i) zz[i] = 0.f;
            D0 = __builtin_amdgcn_mfma_f32_32x32x16_bf16(af, bfr[0], zz, 0, 0, 0);
            D1 = __builtin_amdgcn_mfma_f32_32x32x16_bf16(af, bfr[1], zz, 0, 0, 0);
            D2 = __builtin_amdgcn_mfma_f32_32x32x16_bf16(af, bfr[2], zz, 0, 0, 0);
            D3 = __builtin_amdgcn_mfma_f32_32x32x16_bf16(af, bfr[3], zz, 0, 0, 0);
        }
        if (MODE == 2) {
            const float* sre = P.in[2]; const float* sim = P.in[3];
            float* ore = P.out + O_RES; float* oim = P.out + O_IMS;
            float h0r[16], h0i[16], h1r[16], h1i[16];
#pragma unroll
            for (int s = 0; s < 16; ++s) {
                const size_t o = ((size_t)(b + s + 16 * h) * 32 + g) * 64 + c;
                h0r[s] = sre[o]; h0i[s] = sim[o]; h1r[s] = sre[o + 32]; h1i[s] = sim[o + 32];
            }
#pragma unroll
            for (int s = 0; s < 16; ++s) {
                const size_t o = ((size_t)(b + s + 16 * h) * 32 + g) * 64 + c;
                D0[s] += a0.x * h0r[s] - a0.y * h0i[s]; D2[s] += a0.x * h0i[s] + a0.y * h0r[s];
                D1[s] += a1.x * h1r[s] - a1.y * h1i[s]; D3[s] += a1.x * h1i[s] + a1.y * h1r[s];
                ore[o] = D0[s]; oim[o] = D2[s]; ore[o + 32] = D1[s]; oim[o + 32] = D3[s];
            }
        } else {
            float x0r = h ? 0.f : X0r, x0i = h ? 0.f : X0i, x1r = h ? 0.f : X1r, x1i = h ? 0.f : X1i;
#pragma unroll
            for (int s = 0; s < 16; ++s) {
                const float n0r = a0.x * x0r - a0.y * x0i + D0[s], n0i = a0.x * x0i + a0.y * x0r + D2[s];
                const float n1r = a1.x * x1r - a1.y * x1i + D1[s], n1i = a1.x * x1i + a1.y * x1r + D3[s];
                x0r = n0r; x0i = n0i; x1r = n1r; x1i = n1i;
                D0[s] = x0r; D2[s] = x0i; D1[s] = x1r; D3[s] = x1i;
            }
            const float y0r = __shfl(x0r, c), y0i = __shfl(x0i, c), y1r = __shfl(x1r, c), y1i = __shfl(x1i, c);
            if (MODE == 0) {
                const float2 q0 = tab_ab16[g * 64 + c], q1 = tab_ab16[g * 64 + c + 32];
                const float e0r = x0r + q0.x * y0r - q0.y * y0i, e0i = x0i + q0.x * y0i + q0.y * y0r;
                const float e1r = x1r + q1.x * y1r - q1.y * y1i, e1i = x1i + q1.x * y1i + q1.y * y1r;
                X0r = __shfl(e0r, c + 32); X0i = __shfl(e0i, c + 32); X1r = __shfl(e1r, c + 32); X1i = __shfl(e1i, c + 32);
            } else {
                float c0r = h ? y0r : 0.f, c0i = h ? y0i : 0.f, c1r = h ? y1r : 0.f, c1i = h ? y1i : 0.f;
#pragma unroll
                for (int s = 0; s < 16; ++s) {
                    const float n0r = a0.x * c0r - a0.y * c0i, n0i = a0.x * c0i + a0.y * c0r;
                    const float n1r = a1.x * c1r - a1.y * c1i, n1i = a1.x * c1i + a1.y * c1r;
                    c0r = n0r; c0i = n0i; c1r = n1r; c1i = n1i;
                    D0[s] += c0r; D2[s] += c0i; D1[s] += c1r; D3[s] += c1i;
                }
                X0r = __shfl(D0[15], c + 32); X0i = __shfl(D2[15], c + 32); X1r = __shfl(D1[15], c + 32); X1i = __shfl(D3[15], c + 32);
            }
        }
        if (MODE != 0) {
#pragma unroll
            for (int s = 0; s < 16; ++s) {
                u32x2 w; w.x = cvt_pk_bf16(D0[s], D2[s]); w.y = cvt_pk_bf16(D1[s], D3[s]);
                *(LAS u32x2*)(xs + (s + 16 * h) * XS_STRIDE + c * 8) = w;
            }
            LDS_WAIT();
            const int chn = lane & 15, q = lane >> 4;
#pragma unroll
            for (int tb = 0; tb < 2; ++tb) {
                f32x4 y = (f32x4){0.f, 0.f, 0.f, 0.f};
#pragma unroll
                for (int kk = 0; kk < 4; ++kk) {
                    const bf16x8 xa = *(const LAS bf16x8*)(xs + (tb * 16 + chn) * XS_STRIDE + kk * 64 + q * 16);
                    y = __builtin_amdgcn_mfma_f32_16x16x32_bf16(cfr[kk], xa, y, 0, 0, 0);
                }
                {
                    const int row = rb + tb * 16 + chn;
                    const u32x2 uu = uraw[tb];
                    const float z0 = gelu_tanh(y[0] + dsk4[0] * bflo(uu.x)), z1 = gelu_tanh(y[1] + dsk4[1] * bfhi(uu.x));
                    const float z2 = gelu_tanh(y[2] + dsk4[2] * bflo(uu.y)), z3 = gelu_tanh(y[3] + dsk4[3] * bfhi(uu.y));
                    u32x2 w; w.x = cvt_pk_bf16(z0, z1); w.y = cvt_pk_bf16(z2, z3);
                    *(u32x2*)(zb + (size_t)row * SSMW + g * 16 + 4 * q) = w;
                }
            }
            LDS_WAIT();
        }
    }
    if (MODE == 0) {
        if (h == 0) { Eb[((size_t)(b * NCH + ch) * 32 + g) * 64 + c] = make_float2(X0r, X0i); Eb[((size_t)(b * NCH + ch) * 32 + g) * 64 + c + 32] = make_float2(X1r, X1i); }
    }
    if (MODE == 1) {
        if (ch == NCH - 1 && h == 0) {
            float* ore = P.out + O_REP; float* oim = P.out + O_IMP; const size_t o = ((size_t)b * 32 + g) * 64 + c;
            ore[o] = X0r; oim[o] = X0i; ore[o + 32] = X1r; oim[o + 32] = X1i;
        }
    }
}

template <int MODE>
__device__ __forceinline__ void ssm_pair_item(const Params& P, LAS unsigned char* xs, int lane, int item) {
    unsigned char* ws = P.ws;
    const bf16_t* pb = (const bf16_t*)(ws + WS_P);
    bf16_t* zb = (bf16_t*)(ws + WS_Z);
    const float2* tab_ab = (const float2*)(ws + WS_TAB + T_AB);
    const float2* tab_ab128 = (const float2*)(ws + WS_TAB + T_AB128);
    float2* Eb = (float2*)(ws + WS_E);
    const int c = lane & 31, h = lane >> 5;
    const int g = item & 31, ch = (item >> 5) % NCH, bp = item / (32 * NCH);
    const int bh = 2 * bp + h;
    const float2 a0 = tab_ab[g * 64 + c], a1 = tab_ab[g * 64 + c + 32];
    bf16x8 bfr[4];
#pragma unroll
    for (int nt = 0; nt < 4; ++nt) bfr[nt] = *(const bf16x8*)(ws + WS_TAB + T_BF + ((size_t)(g * 4 + nt) * 64 + lane) * 16);
    bf16x8 cfr[4];
    f32x4 dsk4 = (f32x4){0.f, 0.f, 0.f, 0.f};
    if (MODE != 0) {
#pragma unroll
        for (int kk = 0; kk < 4; ++kk) cfr[kk] = *(const bf16x8*)(ws + WS_TAB + T_CF + ((size_t)(g * 4 + kk) * 64 + lane) * 16);
        dsk4 = *(const f32x4*)(P.in[18] + g * 16 + 4 * (lane >> 4));
    }
    float x0r = 0.f, x0i = 0.f, x1r = 0.f, x1i = 0.f;
    if (MODE == 1) {
        const float2 p0 = tab_ab128[g * 64 + c], p1 = tab_ab128[g * 64 + c + 32];
        const float2* e0p = Eb + ((size_t)(bh * NCH) * 32 + g) * 64 + c;
        for (int cc0 = 0; cc0 < ch; cc0 += 4) {
            float2 e0[4], e1[4];
#pragma unroll
            for (int q = 0; q < 4; ++q) { const int cc = (cc0 + q < ch) ? cc0 + q : ch - 1; e0[q] = e0p[(size_t)cc * 2048]; e1[q] = e0p[(size_t)cc * 2048 + 32]; }
#pragma unroll
            for (int q = 0; q < 4; ++q) if (cc0 + q < ch) {
                const float t0r = p0.x * x0r - p0.y * x0i + e0[q].x, t0i = p0.x * x0i + p0.y * x0r + e0[q].y; x0r = t0r; x0i = t0i;
                const float t1r = p1.x * x1r - p1.y * x1i + e1[q].x, t1i = p1.x * x1i + p1.y * x1r + e1[q].y; x1r = t1r; x1i = t1i;
            }
        }
    }
    const int tok = tau32(c);
    const int arow0 = (2 * bp + (tok >> 4)) * SEQ + ch * TCH + (tok & 15);
    constexpr int NSB = TCH / 16;
#pragma unroll 1
    for (int sq4 = 0; sq4 < NSB / 4; ++sq4) {
    bf16x8 afr[4];
#pragma unroll
    for (int s4 = 0; s4 < 4; ++s4) afr[s4] = *(const bf16x8*)(pb + (size_t)(arow0 + (sq4 * 4 + s4) * 16) * PW + g * 16 + 8 * h);
#pragma unroll
    for (int s4 = 0; s4 < 4; ++s4) {
        const int sb = sq4 * 4 + s4;
        const int rb0 = (2 * bp) * SEQ + ch * TCH + sb * 16;
        const bf16x8 af = afr[s4];
        u32x2 uraw[2];
        if (MODE != 0) {
#pragma unroll
            for (int tb = 0; tb < 2; ++tb) uraw[tb] = *(const u32x2*)(pb + (size_t)(rb0 + tb * SEQ + (lane & 15)) * PW + g * 16 + 4 * (lane >> 4));
        }
        f32x16 D0, D1, D2, D3;
        {
            f32x16 zz;
#pragma unroll
            for (int i = 0; i < 16; ++i) zz[i] = 0.f;
            D0 = __builtin_amdgcn_mfma_f32_32x32x16_bf16(af, bfr[0], zz, 0, 0, 0);
            D1 = __builtin_amdgcn_mfma_f32_32x32x16_bf16(af, bfr[1], zz, 0, 0, 0);
            D2 = __builtin_amdgcn_mfma_f32_32x32x16_bf16(af, bfr[2], zz, 0, 0, 0);
            D3 = __builtin_amdgcn_mfma_f32_32x32x16_bf16(af, bfr[3], zz, 0, 0, 0);
        }
#pragma unroll
        for (int s = 0; s < 16; ++s) {
            const float n0r = a0.x * x0r - a0.y * x0i + D0[s], n0i = a0.x * x0i + a0.y * x0r + D2[s];
            const float n1r = a1.x * x1r - a1.y * x1i + D1[s], n1i = a1.x * x1i + a1.y * x1r + D3[s];
            x0r = n0r; x0i = n0i; x1r = n1r; x1i = n1i;
            D0[s] = x0r; D2[s] = x0i; D1[s] = x1r; D3[s] = x1i;
        }
        if (MODE != 0) {
#pragma unroll
            for (int s = 0; s < 16; ++s) {
                u32x2 w; w.x = cvt_pk_bf16(D0[s], D2[s]); w.y = cvt_pk_bf16(D1[s], D3[s]);
                *(LAS u32x2*)(xs + (s + 16 * h) * XS_STRIDE + c * 8) = w;
            }
            LDS_WAIT();
            const int chn = lane & 15, q = lane >> 4;
#pragma unroll
            for (int tb = 0; tb < 2; ++tb) {
                f32x4 y = (f32x4){0.f, 0.f, 0.f, 0.f};
#pragma unroll
                for (int kk = 0; kk < 4; ++kk) {
                    const bf16x8 xa = *(const LAS bf16x8*)(xs + (tb * 16 + chn) * XS_STRIDE + kk * 64 + q * 16);
                    y = __builtin_amdgcn_mfma_f32_16x16x32_bf16(cfr[kk], xa, y, 0, 0, 0);
                }
                {
                    const int row = rb0 + tb * SEQ + chn;
                    const u32x2 uu = uraw[tb];
                    const float z0 = gelu_tanh(y[0] + dsk4[0] * bflo(uu.x)), z1 = gelu_tanh(y[1] + dsk4[1] * bfhi(uu.x));
                    const float z2 = gelu_tanh(y[2] + dsk4[2] * bflo(uu.y)), z3 = gelu_tanh(y[3] + dsk4[3] * bfhi(uu.y));
                    u32x2 w; w.x = cvt_pk_bf16(z0, z1); w.y = cvt_pk_bf16(z2, z3);
                    *(u32x2*)(zb + (size_t)row * SSMW + g * 16 + 4 * q) = w;
                }
            }
            LDS_WAIT();
        }
        __builtin_amdgcn_sched_barrier(0);
    }
    }
    if (MODE == 0) {
        Eb[((size_t)(bh * NCH + ch) * 32 + g) * 64 + c] = make_float2(x0r, x0i); Eb[((size_t)(bh * NCH + ch) * 32 + g) * 64 + c + 32] = make_float2(x1r, x1i);
    }
    if (MODE == 1) {
        if (ch == NCH - 1) {
            float* ore = P.out + O_REP; float* oim = P.out + O_IMP; const size_t o = ((size_t)bh * 32 + g) * 64 + c;
            ore[o] = x0r; oim[o] = x0i; ore[o + 32] = x1r; oim[o + 32] = x1i;
        }
    }
}

__device__ __forceinline__ void conv_items(const Params& P, int it0, int it1, int stride) {
    unsigned char* ws = P.ws;
    const bf16_t* pbuf = (const bf16_t*)(ws + WS_P);
    bf16_t* mix = (bf16_t*)(ws + WS_MIX);
    const float* cw = P.in[21]; const float* scv = P.in[4];
        for (int it = it0; it < it1; it += stride) {
            const int row = it >> 6, c8 = (it & 63) * 8;
            const bf16_t* pr = pbuf + (size_t)row * PW;
            const u32x4 vc = *(const u32x4*)(pr + 1024 + c8), gb = *(const u32x4*)(pr + 512 + c8);
            float v0[8], v1[8], v2[8], gbf[8];
#pragma unroll
            for (int q = 0; q < 4; ++q) { v0[2 * q] = bflo(vc[q]); v0[2 * q + 1] = bfhi(vc[q]); gbf[2 * q] = bflo(gb[q]); gbf[2 * q + 1] = bfhi(gb[q]); }
            if (row < NPROMPT) {
                const int t = row & (SEQ - 1);
                if (t >= 1) { const u32x4 x1 = *(const u32x4*)(pr - PW + 1024 + c8);
#pragma unroll
                    for (int q = 0; q < 4; ++q) { v1[2 * q] = bflo(x1[q]); v1[2 * q + 1] = bfhi(x1[q]); } }
                else {
#pragma unroll
                    for (int q = 0; q < 8; ++q) v1[q] = 0.f; }
                if (t >= 2) { const u32x4 x2 = *(const u32x4*)(pr - 2 * PW + 1024 + c8);
#pragma unroll
                    for (int q = 0; q < 4; ++q) { v2[2 * q] = bflo(x2[q]); v2[2 * q + 1] = bfhi(x2[q]); } }
                else {
#pragma unroll
                    for (int q = 0; q < 8; ++q) v2[q] = 0.f; }
                if (t == SEQ - 1) { float* o = P.out + O_CVP + (size_t)(row >> 11) * 1024 + c8;
#pragma unroll
                    for (int q = 0; q < 8; ++q) { o[q] = v1[q]; o[512 + q] = v0[q]; } }
            } else {
                const int sb = row - NPROMPT; const float* bf = scv + (size_t)sb * 1024 + c8;
#pragma unroll
                for (int q = 0; q < 8; ++q) { v2[q] = bf[q]; v1[q] = bf[512 + q]; }
                float* o = P.out + O_CVS + (size_t)sb * 1024 + c8;
#pragma unroll
                for (int q = 0; q < 8; ++q) { o[q] = v1[q]; o[512 + q] = v0[q]; }
            }
            float co[8];
#pragma unroll
            for (int q = 0; q < 8; ++q) co[q] = gbf[q] * (cw[c8 + q] * v2[q] + cw[512 + c8 + q] * v1[q] + cw[1024 + c8 + q] * v0[q]);
            u32x4 w; w.x = pk2(co[0], co[1]); w.y = pk2(co[2], co[3]); w.z = pk2(co[4], co[5]); w.w = pk2(co[6], co[7]);
            *(u32x4*)(mix + (size_t)row * DM + 512 + c8) = w;
        }
}

typedef __attribute__((address_space(1))) unsigned gu32;
#define XB_TMO      128
#define XB_XCNT(j)  (256  + 64 * (j))
#define XB_XSUB(j)  (1280 + 64 * (j))
#define XB_XGEN(j)  (2304 + 64 * (j))
#define XB_TOP      3328
#define XB_TOPGEN   3392
#define XCD_BAR_WORDS 3456
#define XB_SPIN_CAP (1u << 18)

__device__ __forceinline__ unsigned xb_ld(unsigned* p)              { return __hip_atomic_load(p, __ATOMIC_RELAXED, __HIP_MEMORY_SCOPE_AGENT); }
__device__ __forceinline__ unsigned xb_add(unsigned* p, unsigned v) { return __hip_atomic_fetch_add(p, v, __ATOMIC_RELAXED, __HIP_MEMORY_SCOPE_AGENT); }
__device__ __forceinline__ unsigned xb_xcc_id() { return (unsigned)__builtin_amdgcn_s_getreg((3 << 11) | 20) & 0xFu; }
#define XB_SPIN(cond, bar) do { unsigned _sp = 0; while (cond) { __builtin_amdgcn_s_sleep(1); \
    if ((++_sp & 255u) == 0u) { if (xb_ld(&(bar)[XB_TMO])) break; if (_sp > XB_SPIN_CAP) { atomicAdd(&(bar)[XB_TMO], 1u); break; } } } } while (0)

struct XcdBarrier {
    unsigned* bar; unsigned x;
    volatile LAS unsigned* st;
};

__device__ __forceinline__ XcdBarrier xcd_barrier_post(unsigned* bar, volatile LAS unsigned* st) {
    XcdBarrier b; b.bar = bar; b.x = xb_xcc_id(); b.st = st;
    if (threadIdx.x == 0) (void)xb_add(&bar[XB_XCNT(b.x)], 1u);
    return b;
}
__device__ __forceinline__ void xcd_barrier_complete(unsigned* bar, unsigned x, unsigned& nloc, unsigned& nx) {
    const unsigned G = gridDim.x * gridDim.y * gridDim.z;
    unsigned sum, cnt, mine, sp = 0u;
    for (;;) {
        sum = 0u; cnt = 0u; mine = 0u;
#pragma unroll
        for (unsigned j = 0; j < 16; ++j) { const unsigned c = xb_ld(&bar[XB_XCNT(j)]); sum += c; cnt += (c > 0u) ? 1u : 0u; mine = (j == x) ? c : mine; }
        if (sum == G) break;
        __builtin_amdgcn_s_sleep(1);
        if ((++sp & 255u) == 0u) { if (xb_ld(&bar[XB_TMO])) break; if (sp > XB_SPIN_CAP) { atomicAdd(&bar[XB_TMO], 1u); break; } }
    }
    nloc = mine > 0u ? mine : 1u; nx = cnt > 0u ? cnt : 1u;
}

__device__ __forceinline__ void xcd_barrier(const XcdBarrier& b) {
    asm volatile("s_waitcnt vmcnt(0)" ::: "memory");
    __syncthreads();
    if (threadIdx.x == 0) {
        unsigned* bar = b.bar;
        __builtin_amdgcn_s_waitcnt(0);
        unsigned nloc = b.st[0], nx = b.st[1];
        if (nloc == 0u) { xcd_barrier_complete(bar, b.x, nloc, nx); b.st[0] = nloc; b.st[1] = nx; }
        const unsigned old = xb_add(&bar[XB_XSUB(b.x)], 1u);
        const unsigned gen = old / nloc;
        if (old + 1u == (gen + 1u) * nloc) {
            __builtin_amdgcn_fence(__ATOMIC_RELEASE, "agent");
            asm volatile("s_waitcnt vmcnt(0)" ::: "memory");
            const unsigned og = xb_add(&bar[XB_TOP], 1u);
            const unsigned tg = og / nx;
            if (og + 1u == (tg + 1u) * nx) xb_add(&bar[XB_TOPGEN], 1u);
            else XB_SPIN(xb_ld(&bar[XB_TOPGEN]) == tg, bar);
            __builtin_amdgcn_fence(__ATOMIC_ACQUIRE, "agent");
            xb_add(&bar[XB_XGEN(b.x)], 1u);
            asm volatile("s_waitcnt vmcnt(0)" ::: "memory");
        } else {
            XB_SPIN(xb_ld(&bar[XB_XGEN(b.x)]) == gen, bar);
            __builtin_amdgcn_fence(__ATOMIC_ACQUIRE, "agent");
            asm volatile("s_waitcnt vmcnt(0)" ::: "memory");
        }
    }
    __syncthreads();
}


__global__ void __launch_bounds__(NTHREADS, 2) hymba_fwd(Params P) {
    extern __shared__ __attribute__((aligned(16))) unsigned char lds_raw[];
    LAS unsigned char* lds = (LAS unsigned char*)lds_raw;
    cg::grid_group grid = cg::this_grid();
    const int tid = threadIdx.x, lane = tid & 63, wave = __builtin_amdgcn_readfirstlane(tid >> 6);
    const int G = gridDim.x, bid = blockIdx.x;
    const int gw = bid * NWAVES + wave, NGW = G * NWAVES;
    unsigned char* ws = P.ws;
    float* ss = (float*)(ws + WS_SS);
    bf16_t* ab = (bf16_t*)(ws + WS_AB);
    bf16_t* act = (bf16_t*)(ws + WS_ACT);
    bf16_t* pbuf = (bf16_t*)(ws + WS_P);
    bf16_t* zbuf = (bf16_t*)(ws + WS_Z);
    bf16_t* mix = (bf16_t*)(ws + WS_MIX);
    const float* xp = P.in[0]; const float* xsamp = P.in[1];
    volatile LAS unsigned* bst = (volatile LAS unsigned*)(lds + 131072 + 512);
    if (tid < 2) bst[tid] = 0u;
    __syncthreads();
    XcdBarrier xbar = xcd_barrier_post((unsigned*)(ws + WS_BAR), bst);

    {
        LAS float* scr = (LAS float*)(lds + wave * 16384);
        transpose_matrix<1>(P.in[6], DM, DFF, (bf16_t*)(ws + WS_WGU1), P.in[5], scr, lane, gw, NGW);
        transpose_matrix<2>(P.in[7], DM, DFF, (bf16_t*)(ws + WS_WGU1), P.in[5], scr, lane, gw, NGW);
        for (int row0 = gw; row0 < MROWS; row0 += 2 * NGW) {
            const int row1 = row0 + NGW; const bool has1 = row1 < MROWS; const int r1c = has1 ? row1 : row0;
            const float* xr0 = row0 < NPROMPT ? xp + (size_t)row0 * DM : xsamp + (size_t)(row0 - NPROMPT) * DM;
            const float* xr1 = r1c < NPROMPT ? xp + (size_t)r1c * DM : xsamp + (size_t)(r1c - NPROMPT) * DM;
            f32x4 v0[4], v1[4];
#pragma unroll
            for (int j = 0; j < 4; ++j) { v0[j] = *(const f32x4*)(xr0 + j * 256 + lane * 4); v1[j] = *(const f32x4*)(xr1 + j * 256 + lane * 4); }
            float s0 = 0.f, s1 = 0.f;
#pragma unroll
            for (int j = 0; j < 4; ++j) {
                s0 += (v0[j][0] * v0[j][0] + v0[j][1] * v0[j][1]) + (v0[j][2] * v0[j][2] + v0[j][3] * v0[j][3]);
                s1 += (v1[j][0] * v1[j][0] + v1[j][1] * v1[j][1]) + (v1[j][2] * v1[j][2] + v1[j][3] * v1[j][3]);
                u32x2 w; w.x = cvt_pk_bf16(v0[j][0], v0[j][1]); w.y = cvt_pk_bf16(v0[j][2], v0[j][3]);
                *(u32x2*)(ab + (size_t)row0 * DM + j * 256 + lane * 4) = w;
                if (has1) { u32x2 w1; w1.x = cvt_pk_bf16(v1[j][0], v1[j][1]); w1.y = cvt_pk_bf16(v1[j][2], v1[j][3]); *(u32x2*)(ab + (size_t)row1 * DM + j * 256 + lane * 4) = w1; }
            }
            s0 = wave_sum(s0); s1 = wave_sum(s1);
            if (lane == 0) { ss[row0] = s0; if (has1) ss[row1] = s1; }
        }
        for (int i = bid * NTHREADS + tid; i < 3 * MP; i += G * NTHREADS) ss[MP + i] = 0.f;
        for (int i = bid * NTHREADS + tid; i < MP - MROWS; i += G * NTHREADS) ss[MROWS + i] = 1024.f;
        if (bid == 0 && tid < 256) ((unsigned*)(ws + WS_CNT))[tid] = 0u;
        {
            float2* t_ab = (float2*)(ws + WS_TAB + T_AB); float2* t_ab16 = (float2*)(ws + WS_TAB + T_AB16); float2* t_ab128 = (float2*)(ws + WS_TAB + T_AB128);
            const float* lre = P.in[11]; const float* lim = P.in[12]; const float* ldt = P.in[13];
            for (int i = bid * NTHREADS + tid; i < NG * NS; i += G * NTHREADS) {
                const int g = i >> 6;
                const float dt = expf(ldt[g]); const float lr = lre[i], li = lim[i];
                const float mag = expf(lr * dt); const float th = li * dt;
                float ar = mag * cosf(th), ai = mag * sinf(th);
                t_ab[i] = make_float2(ar, ai);
                float pr = ar, pi = ai;
#pragma unroll
                for (int k = 0; k < 7; ++k) { const float nr = pr * pr - pi * pi, ni = 2.f * pr * pi; pr = nr; pi = ni; if (k == 3) t_ab16[i] = make_float2(pr, pi); }
                t_ab128[i] = make_float2(pr, pi);
            }
            bf16_t* t_bf = (bf16_t*)(ws + WS_TAB + T_BF); bf16_t* t_cf = (bf16_t*)(ws + WS_TAB + T_CF);
            const float* bre = P.in[14]; const float* bim = P.in[15]; const float* cre = P.in[16]; const float* cim = P.in[17];
            for (int i = bid * NTHREADS + tid; i < NG * 4 * 64 * 8; i += G * NTHREADS) {
                const int j = i & 7, ln = (i >> 3) & 63, nt = (i >> 9) & 3, g = i >> 11;
                {
                    const int st = (nt & 1) * 32 + (ln & 31), part = nt >> 1, chn = 8 * (ln >> 5) + j;
                    const int gi = g * 64 + st;
                    const float dt = expf(ldt[g]); const float lr = lre[gi], li = lim[gi];
                    const float mag = expf(lr * dt); const float th = li * dt;
                    const float ar = mag * cosf(th), ai = mag * sinf(th);
                    const float den = lr * lr + li * li, nr = ar - 1.0f, ni = ai;
                    const float cr = (nr * lr + ni * li) / den, ci = (ni * lr - nr * li) / den;
                    const float br = bre[(size_t)gi * 16 + chn], bi = bim[(size_t)gi * 16 + chn];
                    const float v = part == 0 ? (cr * br - ci * bi) : (cr * bi + ci * br);
                    t_bf[i] = (bf16_t)f2bf(v);
                }
                {
                    const int kk = nt, k = kk * 32 + 8 * (ln >> 4) + j, chn = ln & 15, cc = k >> 2, sel = k & 3;
                    const int st = cc + ((sel >> 1) ? 32 : 0);
                    const size_t ci_ = ((size_t)g * 16 + chn) * 64 + st;
                    const float v = (sel & 1) ? -cim[ci_] : cre[ci_];
                    t_cf[i] = (bf16_t)f2bf(v);
                }
            }
        }
    }
    if (gridDim.y == 7) grid.sync();
    xcd_barrier(xbar);

    {
        pg8::Gemm g{ab, (const bf16_t*)(ws + WS_WGU1), MP, 2 * DFF, DM}; pg8::SplitOrder S; S.init(2 * DFF, DM, 1, G, bid);
        EpiGateUp E{act, ss};
        pg8::gemm_phase<EpiGateUp, pg8::SplitOrder, true, true>(lds, g, S, E, pg8::SplitCtx{nullptr, nullptr, 1});
        const int first_idle = (65 * 22) % G;
        if (bid >= first_idle) {
            LAS float* scr = (LAS float*)(lds + wave * 16384);
            const int w2 = (bid - first_idle) * NWAVES + wave, NW2 = (G - first_idle) * NWAVES;
            transpose_matrix<0>(P.in[8], DFF, DM, (bf16_t*)(ws + WS_WD1), nullptr, scr, lane, w2, NW2);
            transpose_matrix<3>(P.in[10], DM, PW, (bf16_t*)(ws + WS_WIN), P.in[9], scr, lane, w2, NW2);
            transpose_matrix<0>(P.in[19], SSMW, SSMW, (bf16_t*)(ws + WS_WGLU), nullptr, scr, lane, w2, NW2);
            transpose_matrix<0>(P.in[22], DM, DM, (bf16_t*)(ws + WS_WOUT), nullptr, scr, lane, w2, NW2);
        }
    }
    xcd_barrier(xbar);
    {
        pg8::Gemm g{act, (const bf16_t*)(ws + WS_WD1), MP, DM, DFF}; pg8::SplitOrder S; S.init(DM, DFF, 22, G, bid);
        EpiResid<false> E{xp, xsamp, ab, ss + MP, 0.5f};
        pg8::gemm_phase<EpiResid<false>, pg8::SplitOrder, true, true>(lds, g, S, E, pg8::SplitCtx{(float*)(ws + WS_PART), (unsigned*)(ws + WS_CNT), 22});
        sample_finalize<true, true, 22>((const float*)(ws + WS_PART), (unsigned*)(ws + WS_CNT), 22, 88, xsamp, P.out, ab, ss + MP, 0.5f, bid, wave, lane, tid, lds);
    }
    xcd_barrier(xbar);
    {
        pg8::Gemm g{ab, (const bf16_t*)(ws + WS_WIN), MP, PW, DM}; pg8::SplitOrder S; S.init(PW, DM, 1, G, bid, 1);
        EpiInProj E{pbuf, ss + MP};
        pg8::gemm_phase<EpiInProj, pg8::SplitOrder, true, true>(lds, g, S, E, pg8::SplitCtx{nullptr, nullptr, 1});
    }
    xcd_barrier(xbar);
    if (bid < 8) {
        pg8::Gemm g{ab, (const bf16_t*)(ws + WS_WIN), MP, PW, DM}; pg8::SplitOrder S; S.init(PW, DM, 1, G, bid, 2);
        EpiInProj E{pbuf, ss + MP};
        pg8::gemm_phase<EpiInProj, pg8::SplitOrder, true, true>(lds, g, S, E, pg8::SplitCtx{nullptr, nullptr, 1});
    } else {
        LAS unsigned char* xs = lds + wave * XS_BYTES;
        const int gw4 = (bid - 8) * NWAVES + wave, NGW4 = (G - 8) * NWAVES;
        for (int it = gw4; it < NBATCH * NCH * 32; it += NGW4) { if (((it >> 5) % NCH) != NCH - 1) ssm_item<0>(P, xs, lane, it); }
        conv_items(P, (bid - 8) * NTHREADS + tid, NPROMPT * 64, (G - 8) * NTHREADS);
    }
    xcd_barrier(xbar);
    {
        LAS unsigned char* xs = lds + wave * XS_BYTES;
        for (int it = gw; it < (NBATCH / 2) * NCH * 32 + (NSAMP / 32) * 32; it += NGW) {
            if (it < (NBATCH / 2) * NCH * 32) ssm_pair_item<1>(P, xs, lane, it); else ssm_item<2>(P, xs, lane, it - (NBATCH / 2) * NCH * 32);
        }
        conv_items(P, NPROMPT * 64 + bid * NTHREADS + tid, MROWS * 64, G * NTHREADS);
    }
    xcd_barrier(xbar);
    {
        pg8::Gemm g{zbuf, (const bf16_t*)(ws + WS_WGLU), MP, SSMW, SSMW}; pg8::SplitOrder S; S.init(SSMW, SSMW, 1, G, bid);
        EpiGlu E{zbuf, P.in[20], mix};
        pg8::gemm_phase<EpiGlu, pg8::SplitOrder, true, true>(lds, g, S, E, pg8::SplitCtx{nullptr, nullptr, 1});
        const int first_idle = (65 * 2) % G;
        if (bid >= first_idle) {
            LAS float* scr = (LAS float*)(lds + wave * 16384);
            const int w2 = (bid - first_idle) * NWAVES + wave, NW2 = (G - first_idle) * NWAVES;
            transpose_matrix<1>(P.in[24], DM, DFF, (bf16_t*)(ws + WS_WGU2), P.in[23], scr, lane, w2, NW2);
            transpose_matrix<2>(P.in[25], DM, DFF, (bf16_t*)(ws + WS_WGU2), P.in[23], scr, lane, w2, NW2);
        }
    }
    xcd_barrier(xbar);
    {
        pg8::Gemm g{mix, (const bf16_t*)(ws + WS_WOUT), MP, DM, DM}; pg8::SplitOrder S; S.init(DM, DM, 8, G, bid);
        EpiResid<false> E{xp, xsamp, ab, ss + 2 * MP, 1.0f};
        pg8::gemm_phase<EpiResid<false>, pg8::SplitOrder, true, true>(lds, g, S, E, pg8::SplitCtx{(float*)(ws + WS_PART), (unsigned*)(ws + WS_CNT) + 160, 8});
        sample_finalize<true, true, 8>((const float*)(ws + WS_PART), (unsigned*)(ws + WS_CNT) + 160, 8, 32, xsamp, P.out, ab, ss + 2 * MP, 1.0f, bid, wave, lane, tid, lds);
    }
    xcd_barrier(xbar);
    {
        pg8::Gemm g{ab, (const bf16_t*)(ws + WS_WGU2), MP, 2 * DFF, DM}; pg8::SplitOrder S; S.init(2 * DFF, DM, 1, G, bid);
        EpiGateUp E{act, ss + 2 * MP};
        pg8::gemm_phase<EpiGateUp, pg8::SplitOrder, true, true>(lds, g, S, E, pg8::SplitCtx{nullptr, nullptr, 1});
        const int first_idle = (65 * 22) % G;
        if (bid >= first_idle) {
            LAS float* scr = (LAS float*)(lds + wave * 16384);
            const int w2 = (bid - first_idle) * NWAVES + wave, NW2 = (G - first_idle) * NWAVES;
            transpose_matrix<0>(P.in[26], DFF, DM, (bf16_t*)(ws + WS_WD2), nullptr, scr, lane, w2, NW2);
        }
    }
    xcd_barrier(xbar);
    {
        pg8::Gemm g{act, (const bf16_t*)(ws + WS_WD2), MP, DM, DFF}; pg8::SplitOrder S; S.init(DM, DFF, 22, G, bid);
        EpiFinal E{P.out, ab, ss + 3 * MP, (unsigned*)(ws + WS_CNT) + 64, P.in[27], 0.5f};
        pg8::gemm_phase<EpiFinal, pg8::SplitOrder, true, true>(lds, g, S, E, pg8::SplitCtx{(float*)(ws + WS_PART), (unsigned*)(ws + WS_CNT) + 32, 22});
        sample_finalize_norm<22>((const float*)(ws + WS_PART), (unsigned*)(ws + WS_CNT) + 32, 22, 88, P.out, ab, P.in[27], 0.5f, bid, wave, lane, tid, lds);
    }
}

extern "C" void kernel_launch(void* const* d_in, const int* in_sizes, int n_in, void* d_out, int out_size, void* d_ws, size_t ws_size, hipStream_t stream) {
    static int grid_blocks = 0;
    if (grid_blocks == 0) {
        if (n_in != 28 || ws_size < WS_END) { fprintf(stderr, "kernel_launch: unexpected n_in %d / ws %zu\n", n_in, ws_size); grid_blocks = -1; return; }
        int dev = 0, cus = 0, per_cu = 0;
        hipGetDevice(&dev);
        hipDeviceGetAttribute(&cus, hipDeviceAttributeMultiprocessorCount, dev);
        if (hipFuncSetAttribute((const void*)hymba_fwd, hipFuncAttributeMaxDynamicSharedMemorySize, LDS_BYTES) != hipSuccess) { fprintf(stderr, "kernel_launch: hipFuncSetAttribute failed\n"); grid_blocks = -1; return; }
        if (hipOccupancyMaxActiveBlocksPerMultiprocessor(&per_cu, (const void*)hymba_fwd, NTHREADS, LDS_BYTES) != hipSuccess || per_cu < 1) { fprintf(stderr, "kernel_launch: occupancy query gave %d\n", per_cu); per_cu = 1; }
        (void)hipGetLastError();
        grid_blocks = cus * 1;
        fprintf(stderr, "kernel_launch: cus %d per_cu %d grid %d\n", cus, per_cu, grid_blocks);
    }
    if (grid_blocks < 0) return;
    Params p{};
    for (int i = 0; i < 28; ++i) p.in[i] = (const float*)d_in[i];
    p.out = (float*)d_out; p.ws = (unsigned char*)d_ws;
    if (hipMemsetAsync((char*)d_ws + WS_BAR, 0, 16384, stream) != hipSuccess) { fprintf(stderr, "kernel_launch: memset failed\n"); return; }
    void* args[] = {&p};
    hipError_t e = hipLaunchCooperativeKernel((const void*)hymba_fwd, dim3(grid_blocks), dim3(NTHREADS), args, LDS_BYTES, stream);
    if (e != hipSuccess) fprintf(stderr, "cooperative launch failed: %s (grid %d)\n", hipGetErrorString(e), grid_blocks);
}
```

```cpp
#include <hip/hip_runtime.h>
#include <hip/hip_cooperative_groups.h>
#include <cstdio>
#include <cstdint>
namespace cg = cooperative_groups;

#define LAS __attribute__((address_space(3)))
typedef unsigned short bf16_t;
typedef short bf16x8 __attribute__((ext_vector_type(8)));
typedef float f32x4 __attribute__((ext_vector_type(4)));
typedef float f32x16 __attribute__((ext_vector_type(16)));
typedef unsigned u32x4 __attribute__((ext_vector_type(4)));
typedef unsigned u32x2 __attribute__((ext_vector_type(2)));

constexpr int DM = 1024, NPROMPT = 16384, NSAMP = 128, MROWS = NPROMPT + NSAMP, MP = 16640, DFF = 2816, SEQ = 2048, NBATCH = 8;
constexpr int NG = 32, NS = 64, PW = 2048, SSMW = 512;
constexpr int TCH = 128, NCH = SEQ / TCH;
constexpr float EPS = 1e-6f;
constexpr int NWAVES = 8, NTHREADS = 512;
constexpr int LDS_BYTES = 147456;

constexpr size_t O_REP = (size_t)MROWS * DM, O_IMP = O_REP + 16384, O_CVP = O_IMP + 16384, O_RES = O_CVP + 8192, O_IMS = O_RES + 262144, O_CVS = O_IMS + 262144;

constexpr size_t MiB = 1u << 20;
constexpr size_t WS_SS = 0;
constexpr size_t WS_TAB = 1 * MiB;
constexpr size_t T_AB = 0, T_AB16 = 16384, T_AB128 = 32768, T_BF = 49152, T_CF = T_BF + 131072;
constexpr size_t WS_WGU1 = 4 * MiB, WS_WD1 = WS_WGU1 + 11 * MiB, WS_WIN = WS_WD1 + 5632 * 1024, WS_WGLU = WS_WIN + 4 * MiB, WS_WOUT = WS_WGLU + 512 * 1024,
                 WS_WGU2 = WS_WOUT + 2 * MiB, WS_WD2 = WS_WGU2 + 11 * MiB;
constexpr size_t WS_AB = 44 * MiB;
constexpr size_t WS_ACT = 77 * MiB;
constexpr size_t WS_P = WS_ACT, WS_Z = WS_ACT + 65 * MiB;
constexpr size_t WS_MIX = 167 * MiB;
constexpr size_t WS_E = 200 * MiB;
constexpr size_t WS_PART = 202 * MiB;
constexpr size_t WS_BAR = 768 * 1024;
constexpr size_t WS_CNT = 512 * 1024;
constexpr size_t WS_END = 214 * MiB;

struct Params { const float* in[28]; float* out; unsigned char* ws; };

__device__ __forceinline__ unsigned f2bf(float f) { unsigned u = __builtin_bit_cast(unsigned, f); return (u + 0x7fffu + ((u >> 16) & 1u)) >> 16; }
__device__ __forceinline__ unsigned cvt_pk_bf16(float lo, float hi) { unsigned r; asm("v_cvt_pk_bf16_f32 %0, %1, %2" : "=v"(r) : "v"(lo), "v"(hi)); return r; }
__device__ __forceinline__ unsigned pk2(float lo, float hi) { return cvt_pk_bf16(lo, hi); }
__device__ __forceinline__ float bf2f(unsigned short b) { return __builtin_bit_cast(float, (unsigned)b << 16); }
__device__ __forceinline__ float bflo(unsigned w) { return __builtin_bit_cast(float, w << 16); }
__device__ __forceinline__ float bfhi(unsigned w) { return __builtin_bit_cast(float, w & 0xffff0000u); }
__device__ __forceinline__ float sigmoidf_(float x) { return __builtin_amdgcn_rcpf(1.0f + __builtin_amdgcn_exp2f(-1.4426950408889634f * x)); }
__device__ __forceinline__ float gelu_tanh(float y) { const float v = 0.7978845608028654f * (y + 0.044715f * y * y * y); return y * __builtin_amdgcn_rcpf(1.0f + __builtin_amdgcn_exp2f(-2.8853900817779268f * v)); }
__device__ __forceinline__ float wave_sum(float v) {
#pragma unroll
    for (int o = 1; o < 64; o <<= 1) v += __shfl_xor(v, o);
    return v;
}
#define LDS_WAIT() asm volatile("s_waitcnt lgkmcnt(0)" ::: "memory")

namespace pg8 {
constexpr int BM = 256, BK = 64, HALF = 128, HTB = HALF * BK * 2, STAGE_BYTES = 8 * HTB, NXCD = 8, WGM = 8;
__host__ __device__ __forceinline__ int lds_byte(int r, int c) { const int st = (r >> 4) * 2 + (c >> 5), rr = r & 15, cc = c & 31, ob = rr * 64 + cc * 2; return st * 1024 + (ob ^ (((ob >> 9) & 1) << 5)); }
__host__ __device__ __forceinline__ void stage_rc(int b, int& R, int& C) { const int st = b / 1024, sb = b % 1024, swz = sb ^ (((sb >> 9) & 1) << 5); R = (st >> 1) * 16 + swz / 64; C = (st & 1) * 32 + (swz % 64) / 2; }
__host__ __device__ __forceinline__ int perm32(int rho) { const int n = rho >> 4, i = rho & 15; return 8 * (i >> 2) + 4 * n + (i & 3); }
struct Unit { int pm, pn, k0, nt, split; };
struct Gemm { const bf16_t* A; const bf16_t* Bt; int M, N, K; };
struct SplitOrder {
    int nN, nwgp, nks, ntk, ntf, G, c, which;
    __device__ void init(int N, int K, int nks_, int G_, int c_, int which_ = 0) { nN = N / BM; nwgp = 64 * nN; nks = nks_; ntf = K / BK; ntk = ntf / nks_; G = G_; c = c_; which = which_; }
    __device__ bool next(int i, Unit& u) const {
        int L = i * G + c;
        if (which == 2) { if (L >= nN * nks) return false; const int ks = L / nN; u.pm = 64; u.pn = L % nN; u.k0 = ks * ntk; u.nt = ntk; u.split = nks > 1 ? ks : -1; return true; }
        const int nsp = nks > 1 ? nN * nks : 0;
        if (L < nsp) { const int ks = L / nN; u.pm = 64; u.pn = L % nN; u.k0 = ks * ntk; u.nt = ntk; u.split = ks; return true; }
        L -= nsp;
        if (L < nwgp) {
            const int q = nwgp / NXCD, xcd = L % NXCD, off = L / NXCD; const int wgid = xcd * q + off;
            const int nig = WGM * nN, gid = wgid / nig, fm = gid * WGM;
            u.pm = fm + ((wgid % nig) % WGM); u.pn = (wgid % nig) / WGM; u.k0 = 0; u.nt = ntf; u.split = -1; return true;
        }
        if (nks > 1 || which == 1) return false;
        const int j = L - nwgp; if (j >= nN) return false;
        u.pm = 64; u.pn = j; u.k0 = 0; u.nt = ntf; u.split = -1; return true;
    }
};
struct SplitCtx { float* part; unsigned* cnt; int nks; };
template <class Epi, class Sched, bool ALIGN_EPI, bool SP2>
__device__ __forceinline__ void gemm_phase(LAS unsigned char* lds, const Gemm g, const Sched& S, const Epi& E, const SplitCtx sc) {
    int tid_ = threadIdx.x; asm volatile("" : "+v"(tid_));
    const int tid = tid_, wid = __builtin_amdgcn_readfirstlane(tid >> 6), lane = tid & 63, wr = wid >> 2, wc = wid & 3, fr = lane & 15, fq = lane >> 4;
    const int K = g.K;
    unsigned voffA[2], voffB[2];
#pragma unroll
    for (int i = 0; i < 2; ++i) { int R, C; stage_rc(tid * 16 + i * 8192, R, C); const int Rb = Epi::PERM ? ((R & ~31) + perm32(R & 31)) : R;
        voffA[i] = (unsigned)(R * K + C) * 2u; voffB[i] = (unsigned)(Rb * K + C) * 2u; }
    const size_t kstep = (size_t)(BK * 2);
    const size_t hstep = (size_t)HALF * K * 2;
    const size_t tstep = 2 * hstep;
    const unsigned ldsw = (unsigned)wid * 1024u;
    const int aoff = lds_byte(wr * 64 + fr, fq * 8), boff = lds_byte(wc * 32 + fr, fq * 8);
#define PG8_SA(b, h) (((b) * 2 + (h)) * HTB)
#define PG8_SB(b, h) ((4 + (b) * 2 + (h)) * HTB)
#define PG8_STAGE(bufoff, gbase, voff) do { _Pragma("unroll") for (int _i = 0; _i < 2; ++_i) \
        __builtin_amdgcn_global_load_lds((const unsigned*)((const char*)(gbase) + (voff)[_i]), (LAS unsigned*)(lds + (bufoff) + ldsw + _i * 8192), 16, 0, 0); } while (0)
#define PG8_LDA(dst, b, h) do { _Pragma("unroll") for (int m = 0; m < 4; ++m) _Pragma("unroll") for (int k = 0; k < 2; ++k) dst[m][k] = *(const LAS bf16x8*)(lds + PG8_SA(b, h) + aoff + m * 2048 + k * 1024); } while (0)
#define PG8_LDB(dst, b, h) do { _Pragma("unroll") for (int n = 0; n < 2; ++n) _Pragma("unroll") for (int k = 0; k < 2; ++k) dst[n][k] = *(const LAS bf16x8*)(lds + PG8_SB(b, h) + boff + n * 2048 + k * 1024); } while (0)
#define PG8_MMA(ai, bj, At, Bt) do { __builtin_amdgcn_s_setprio(1); _Pragma("unroll") for (int m = 0; m < 4; ++m) _Pragma("unroll") for (int n = 0; n < 2; ++n) _Pragma("unroll") for (int k = 0; k < 2; ++k) \
        acc[ai][bj][m][n] = __builtin_amdgcn_mfma_f32_16x16x32_bf16(Bt[n][k], At[m][k], acc[ai][bj][m][n], 0, 0, 0); __builtin_amdgcn_s_setprio(0); } while (0)
#define PG8_WAIT_V(n) asm volatile("s_waitcnt vmcnt(" #n ")" ::: "memory")
#define PG8_WAIT_L(n) asm volatile("s_waitcnt lgkmcnt(" #n ")" ::: "memory")
#define PG8_BAR __builtin_amdgcn_s_barrier()
#define PG8_SCHED __builtin_amdgcn_sched_barrier(0)
    Unit cur, nxt; int ui = 0;
    if (!S.next(0, cur)) return;
    f32x4 acc[2][2][4][2];
#pragma unroll
    for (int a = 0; a < 2; ++a)
#pragma unroll
        for (int b = 0; b < 2; ++b)
#pragma unroll
            for (int m = 0; m < 4; ++m)
#pragma unroll
                for (int n = 0; n < 2; ++n) acc[a][b][m][n] = (f32x4){0.f, 0.f, 0.f, 0.f};
    bf16x8 At[4][2], B0[2][2], B1[2][2];
    const char* cA = (const char*)g.A + (size_t)cur.pm * tstep + (size_t)cur.k0 * kstep; const char* cB = (const char*)g.Bt + (size_t)cur.pn * tstep + (size_t)cur.k0 * kstep;
    if constexpr (SP2) {
        PG8_STAGE(PG8_SB(0, 0), cB, voffB); PG8_STAGE(PG8_SB(0, 1), cB + hstep, voffB); PG8_STAGE(PG8_SA(0, 0), cA, voffA); PG8_STAGE(PG8_SA(0, 1), cA + hstep, voffA);
        if (wr == 1) PG8_BAR;
        PG8_WAIT_V(2); PG8_BAR;
        PG8_STAGE(PG8_SB(1, 0), cB + kstep, voffB); PG8_STAGE(PG8_SA(1, 0), cA + kstep, voffA); PG8_STAGE(PG8_SB(1, 1), cB + hstep + kstep, voffB);
        PG8_WAIT_V(6); PG8_BAR;
    } else {
        PG8_STAGE(PG8_SB(0, 0), cB, voffB); PG8_STAGE(PG8_SA(0, 0), cA, voffA); PG8_STAGE(PG8_SB(0, 1), cB + hstep, voffB); PG8_STAGE(PG8_SA(0, 1), cA + hstep, voffA);
        if (wr == 1) PG8_BAR;
        PG8_WAIT_V(4); PG8_BAR;
        PG8_STAGE(PG8_SB(1, 0), cB + kstep, voffB); PG8_STAGE(PG8_SA(1, 0), cA + kstep, voffA); PG8_STAGE(PG8_SB(1, 1), cB + hstep + kstep, voffB);
        PG8_WAIT_V(6); PG8_BAR;
    }
    for (;;) {
        const bool has_next = S.next(ui + 1, nxt);
        const char* nA = has_next ? (const char*)g.A + (size_t)nxt.pm * tstep + (size_t)nxt.k0 * kstep : cA; const char* nB = has_next ? (const char*)g.Bt + (size_t)nxt.pn * tstep + (size_t)nxt.k0 * kstep : cB;
        const int nt = cur.nt;
        for (int t = 0; t < nt; t += 2) {
            const bool last = (t == nt - 2);
            const char* a1 = cA + (size_t)(t + 1) * kstep;
            const char* a2 = last ? nA : cA + (size_t)(t + 2) * kstep; const char* b2 = last ? nB : cB + (size_t)(t + 2) * kstep;
            const char* a3 = a2 + kstep; const char* b3 = b2 + kstep;
            if constexpr (SP2) {
            PG8_LDB(B0, 0, 0); PG8_LDB(B1, 0, 1); PG8_SCHED; PG8_LDA(At, 0, 0); PG8_STAGE(PG8_SA(1, 1), a1 + hstep, voffA);
            PG8_WAIT_V(8); PG8_WAIT_L(0); PG8_BAR; PG8_MMA(0, 0, At, B0); PG8_MMA(0, 1, At, B1); PG8_BAR; PG8_SCHED;
            PG8_LDA(At, 0, 1); PG8_STAGE(PG8_SB(0, 0), b2, voffB); PG8_STAGE(PG8_SB(0, 1), b2 + hstep, voffB); PG8_STAGE(PG8_SA(0, 0), a2, voffA);
            PG8_WAIT_V(8); PG8_WAIT_L(0); PG8_BAR; PG8_MMA(1, 0, At, B0); PG8_MMA(1, 1, At, B1); PG8_BAR; PG8_SCHED;
            PG8_LDB(B0, 1, 0); PG8_LDB(B1, 1, 1); PG8_SCHED; PG8_LDA(At, 1, 0); PG8_STAGE(PG8_SA(0, 1), a2 + hstep, voffA);
            PG8_WAIT_V(8); PG8_WAIT_L(0); PG8_BAR; PG8_MMA(0, 0, At, B0); PG8_MMA(0, 1, At, B1); PG8_BAR; PG8_SCHED;
            PG8_LDA(At, 1, 1); PG8_STAGE(PG8_SB(1, 0), b3, voffB); PG8_STAGE(PG8_SB(1, 1), b3 + hstep, voffB); PG8_STAGE(PG8_SA(1, 0), a3, voffA);
            PG8_WAIT_V(8); PG8_WAIT_L(0); PG8_BAR; PG8_MMA(1, 0, At, B0); PG8_MMA(1, 1, At, B1); PG8_BAR; PG8_SCHED;
            } else {
            PG8_LDB(B0, 0, 0); PG8_SCHED; PG8_LDA(At, 0, 0); PG8_STAGE(PG8_SA(1, 1), a1 + hstep, voffA);
            PG8_WAIT_L(8); PG8_BAR; PG8_WAIT_L(0); PG8_MMA(0, 0, At, B0); PG8_BAR; PG8_SCHED;
            PG8_LDB(B1, 0, 1); PG8_STAGE(PG8_SB(0, 0), b2, voffB);
            PG8_BAR; PG8_WAIT_L(0); PG8_MMA(0, 1, At, B1); PG8_BAR;
            PG8_LDA(At, 0, 1); PG8_STAGE(PG8_SA(0, 0), a2, voffA);
            PG8_BAR; PG8_WAIT_L(0); PG8_MMA(1, 0, At, B0); PG8_BAR; PG8_SCHED;
            PG8_STAGE(PG8_SB(0, 1), b2 + hstep, voffB);
            PG8_WAIT_V(6); PG8_BAR; PG8_MMA(1, 1, At, B1); PG8_BAR;
            PG8_LDB(B0, 1, 0); PG8_SCHED; PG8_LDA(At, 1, 0); PG8_STAGE(PG8_SA(0, 1), a2 + hstep, voffA);
            PG8_WAIT_L(8); PG8_BAR; PG8_WAIT_L(0); PG8_MMA(0, 0, At, B0); PG8_BAR; PG8_SCHED;
            PG8_LDB(B1, 1, 1); PG8_STAGE(PG8_SB(1, 0), b3, voffB);
            PG8_BAR; PG8_WAIT_L(0); PG8_MMA(0, 1, At, B1); PG8_BAR;
            PG8_LDA(At, 1, 1); PG8_STAGE(PG8_SA(1, 0), a3, voffA);
            PG8_BAR; PG8_WAIT_L(0); PG8_MMA(1, 0, At, B0); PG8_BAR; PG8_SCHED;
            PG8_STAGE(PG8_SB(1, 1), b3 + hstep, voffB);
            PG8_WAIT_V(6); PG8_BAR; PG8_MMA(1, 1, At, B1); PG8_BAR;
            }
        }
        if constexpr (ALIGN_EPI) { if (wr == 0) PG8_BAR; }
        if (cur.split < 0) E(acc, cur, wr, wc, fr, fq);
        else {
            float* slab = sc.part + (size_t)cur.split * (128 * g.N) + cur.pn * 256;
#pragma unroll
            for (int m = 0; m < 4; ++m)
#pragma unroll
                for (int bj = 0; bj < 2; ++bj)
#pragma unroll
                    for (int n = 0; n < 2; ++n) *(f32x4*)(slab + (size_t)(wr * 64 + m * 16 + fr) * g.N + bj * 128 + wc * 32 + (Epi::PERM ? 8 * fq + 4 * n : n * 16 + 4 * fq)) = acc[0][bj][m][n];
            asm volatile("s_waitcnt vmcnt(0) lgkmcnt(0)" ::: "memory"); __builtin_amdgcn_s_barrier(); asm volatile("" ::: "memory");
            if (tid == 0) {
                __builtin_amdgcn_fence(__ATOMIC_RELEASE, "agent");
                asm volatile("s_waitcnt vmcnt(0)" ::: "memory");
                __hip_atomic_fetch_add(sc.cnt, 1u, __ATOMIC_RELAXED, __HIP_MEMORY_SCOPE_AGENT);
            }
        }
        if (!has_next) break;
#pragma unroll
        for (int a = 0; a < 2; ++a)
#pragma unroll
            for (int b = 0; b < 2; ++b)
#pragma unroll
                for (int m = 0; m < 4; ++m)
#pragma unroll
                    for (int n = 0; n < 2; ++n) acc[a][b][m][n] = (f32x4){0.f, 0.f, 0.f, 0.f};
        cur = nxt; cA = nA; cB = nB; ++ui;
        if constexpr (ALIGN_EPI) { if (wr == 1) PG8_BAR; }
    }
    PG8_WAIT_V(0);
    if constexpr (!ALIGN_EPI) { if (wr == 0) PG8_BAR; }
    PG8_BAR;
#undef PG8_SA
#undef PG8_SB
#undef PG8_STAGE
#undef PG8_LDA
#undef PG8_LDB
#undef PG8_MMA
#undef PG8_WAIT_V
#undef PG8_WAIT_L
#undef PG8_BAR
#undef PG8_SCHED
}
}

struct EpiGateUp {
    static constexpr bool PERM = true;
    bf16_t* act; const float* ss;
    __device__ __forceinline__ void operator()(const f32x4 (&acc)[2][2][4][2], const pg8::Unit& u, int wr, int wc, int fr, int fq) const {
        float ssv[2][4];
#pragma unroll
        for (int ai = 0; ai < 2; ++ai)
#pragma unroll
            for (int m = 0; m < 4; ++m) ssv[ai][m] = ss[u.pm * 256 + ai * 128 + wr * 64 + m * 16 + fr];
#pragma unroll
        for (int ai = 0; ai < 2; ++ai)
#pragma unroll
            for (int m = 0; m < 4; ++m) {
                const int row = u.pm * 256 + ai * 128 + wr * 64 + m * 16 + fr;
                const float rs = __builtin_amdgcn_rsqf(ssv[ai][m] * (1.0f / DM) + EPS);
                float v[8];
#pragma unroll
                for (int n = 0; n < 2; ++n)
#pragma unroll
                    for (int i = 0; i < 4; ++i) { const float gt = acc[ai][0][m][n][i] * rs, up = acc[ai][1][m][n][i] * rs; v[n * 4 + i] = gt * sigmoidf_(gt) * up; }
                u32x4 w; w.x = pk2(v[0], v[1]); w.y = pk2(v[2], v[3]); w.z = pk2(v[4], v[5]); w.w = pk2(v[6], v[7]);
                *(u32x4*)(act + (size_t)row * DFF + u.pn * 128 + wc * 32 + 8 * fq) = w;
            }
    }
};
template <bool BASE_X> struct EpiResid {
    static constexpr bool PERM = true;
    const float* xp; const float* xs; bf16_t* hb; float* ssn; float scale;
    __device__ __forceinline__ void operator()(const f32x4 (&acc)[2][2][4][2], const pg8::Unit& u, int wr, int wc, int fr, int fq) const {
#pragma unroll
        for (int ai = 0; ai < 2; ++ai) {
            u32x2 hw[4][2][2];
#pragma unroll
            for (int m = 0; m < 4; ++m) {
                const int row = u.pm * 256 + ai * 128 + wr * 64 + m * 16 + fr;
#pragma unroll
                for (int bj = 0; bj < 2; ++bj)
#pragma unroll
                    for (int n = 0; n < 2; ++n) hw[m][bj][n] = *(const u32x2*)(hb + (size_t)row * DM + u.pn * 256 + bj * 128 + wc * 32 + 8 * fq + 4 * n);
            }
#pragma unroll
            for (int m = 0; m < 4; ++m) {
                const int row = u.pm * 256 + ai * 128 + wr * 64 + m * 16 + fr;
                float sq = 0.f;
#pragma unroll
                for (int bj = 0; bj < 2; ++bj)
#pragma unroll
                    for (int n = 0; n < 2; ++n) {
                        const int col = u.pn * 256 + bj * 128 + wc * 32 + 8 * fq + 4 * n;
                        const u32x2 h2 = hw[m][bj][n];
                        const f32x4 hv = (f32x4){bflo(h2.x), bfhi(h2.x), bflo(h2.y), bfhi(h2.y)} + acc[ai][bj][m][n] * scale;
                        u32x2 w; w.x = pk2(hv[0], hv[1]); w.y = pk2(hv[2], hv[3]);
                        *(u32x2*)(hb + (size_t)row * DM + col) = w;
                        sq += (hv[0] * hv[0] + hv[1] * hv[1]) + (hv[2] * hv[2] + hv[3] * hv[3]);
                    }
                sq += __shfl_xor(sq, 16); sq += __shfl_xor(sq, 32);
                if (fq == 0) atomicAdd(ssn + row, sq);
            }
        }
    }
};
struct EpiFinal {
    static constexpr bool PERM = true;
    float* out; const bf16_t* hb; float* ssn; unsigned* pcnt; const float* gamma; float scale;
    __device__ __forceinline__ void operator()(f32x4 (&acc)[2][2][4][2], const pg8::Unit& u, int wr, int wc, int fr, int fq) const {
#pragma unroll
        for (int ai = 0; ai < 2; ++ai) {
            u32x2 hwv[4][2][2];
#pragma unroll
            for (int m = 0; m < 4; ++m) {
                const int row = u.pm * 256 + ai * 128 + wr * 64 + m * 16 + fr;
#pragma unroll
                for (int bj = 0; bj < 2; ++bj)
#pragma unroll
                    for (int n = 0; n < 2; ++n) hwv[m][bj][n] = *(const u32x2*)(hb + (size_t)row * DM + u.pn * 256 + bj * 128 + wc * 32 + 8 * fq + 4 * n);
            }
#pragma unroll
            for (int m = 0; m < 4; ++m) {
                const int row = u.pm * 256 + ai * 128 + wr * 64 + m * 16 + fr;
                float sq = 0.f;
#pragma unroll
                for (int bj = 0; bj < 2; ++bj)
#pragma unroll
                    for (int n = 0; n < 2; ++n) {
                        const u32x2 hw = hwv[m][bj][n];
                        const f32x4 hv = (f32x4){bflo(hw.x), bfhi(hw.x), bflo(hw.y), bfhi(hw.y)} + acc[ai][bj][m][n] * scale;
                        acc[ai][bj][m][n] = hv;
                        sq += (hv[0] * hv[0] + hv[1] * hv[1]) + (hv[2] * hv[2] + hv[3] * hv[3]);
                    }
                sq += __shfl_xor(sq, 16); sq += __shfl_xor(sq, 32);
                if (fq == 0) atomicAdd(ssn + row, sq);
            }
        }
        asm volatile("s_waitcnt vmcnt(0) lgkmcnt(0)" ::: "memory"); __builtin_amdgcn_s_barrier(); asm volatile("" ::: "memory");
        if (wr == 0 && wc == 0 && fr == 0 && fq == 0) {
            __builtin_amdgcn_fence(__ATOMIC_RELEASE, "agent");
            asm volatile("s_waitcnt vmcnt(0)" ::: "memory");
            __hip_atomic_fetch_add(pcnt + u.pm, 1u, __ATOMIC_RELAXED, __HIP_MEMORY_SCOPE_AGENT);
            unsigned sp = 0;
            while (__hip_atomic_load(pcnt + u.pm, __ATOMIC_RELAXED, __HIP_MEMORY_SCOPE_AGENT) < 4u) { __builtin_amdgcn_s_sleep(1); if (++sp > (1u << 22)) break; }
            __builtin_amdgcn_fence(__ATOMIC_ACQUIRE, "agent");
            asm volatile("s_waitcnt vmcnt(0)" ::: "memory");
        }
        asm volatile("s_waitcnt vmcnt(0) lgkmcnt(0)" ::: "memory"); __builtin_amdgcn_s_barrier(); asm volatile("" ::: "memory");
        float sv[2][4]; f32x4 gnv[2][2];
#pragma unroll
        for (int ai = 0; ai < 2; ++ai)
#pragma unroll
            for (int m = 0; m < 4; ++m) sv[ai][m] = __hip_atomic_load(ssn + u.pm * 256 + ai * 128 + wr * 64 + m * 16 + fr, __ATOMIC_RELAXED, __HIP_MEMORY_SCOPE_AGENT);
#pragma unroll
        for (int bj = 0; bj < 2; ++bj)
#pragma unroll
            for (int n = 0; n < 2; ++n) gnv[bj][n] = *(const f32x4*)(gamma + u.pn * 256 + bj * 128 + wc * 32 + 8 * fq + 4 * n);
#pragma unroll
        for (int ai = 0; ai < 2; ++ai)
#pragma unroll
            for (int m = 0; m < 4; ++m) {
                const int row = u.pm * 256 + ai * 128 + wr * 64 + m * 16 + fr;
                const float rs = __builtin_amdgcn_rsqf(sv[ai][m] * (1.0f / DM) + EPS);
#pragma unroll
                for (int bj = 0; bj < 2; ++bj)
#pragma unroll
                    for (int n = 0; n < 2; ++n) {
                        const int col = u.pn * 256 + bj * 128 + wc * 32 + 8 * fq + 4 * n;
                        *(f32x4*)(out + (size_t)row * DM + col) = acc[ai][bj][m][n] * rs * gnv[bj][n];
                    }
            }
    }
};
struct EpiInProj {
    static constexpr bool PERM = true;
    bf16_t* p; const float* ss;
    __device__ __forceinline__ void operator()(const f32x4 (&acc)[2][2][4][2], const pg8::Unit& u, int wr, int wc, int fr_, int fq_) const {
        int fr = fr_, fq = fq_; asm volatile("" : "+v"(fr), "+v"(fq));
#pragma unroll
        for (int ai = 0; ai < 2; ++ai)
#pragma unroll
            for (int m = 0; m < 4; ++m) {
                const int row = u.pm * 256 + ai * 128 + wr * 64 + m * 16 + fr;
                const float rs = __builtin_amdgcn_rsqf(ss[row] * (1.0f / DM) + EPS);
                if (u.pn < 4) {
#pragma unroll
                    for (int bj = 0; bj < 2; ++bj) {
                        const f32x4 a = acc[ai][bj][m][0] * rs, b = acc[ai][bj][m][1] * rs;
                        u32x4 w; w.x = pk2(a[0], a[1]); w.y = pk2(a[2], a[3]); w.z = pk2(b[0], b[1]); w.w = pk2(b[2], b[3]);
                        *(u32x4*)(p + (size_t)row * PW + u.pn * 256 + bj * 128 + wc * 32 + 8 * fq) = w;
                    }
                } else {
                    const float r2 = rs * rs;
                    const f32x4 a = acc[ai][0][m][0] * acc[ai][1][m][0] * r2, b = acc[ai][0][m][1] * acc[ai][1][m][1] * r2;
                    u32x4 w; w.x = pk2(a[0], a[1]); w.y = pk2(a[2], a[3]); w.z = pk2(b[0], b[1]); w.w = pk2(b[2], b[3]);
                    *(u32x4*)(p + (size_t)row * PW + 1024 + (u.pn - 4) * 128 + wc * 32 + 8 * fq) = w;
                }
            }
    }
};
struct EpiPartOnly {
    static constexpr bool PERM = true;
    __device__ __forceinline__ void operator()(const f32x4 (&)[2][2][4][2], const pg8::Unit&, int, int, int, int) const {}
};
struct EpiGlu {
    static constexpr bool PERM = true;
    const bf16_t* z; const float* bias; bf16_t* mix;
    __device__ __forceinline__ void operator()(const f32x4 (&acc)[2][2][4][2], const pg8::Unit& u, int wr, int wc, int fr, int fq) const {
#pragma unroll
        for (int bj = 0; bj < 2; ++bj) {
            const int col = u.pn * 256 + bj * 128 + wc * 32 + 8 * fq;
            const f32x4 b0 = *(const f32x4*)(bias + col), b1 = *(const f32x4*)(bias + col + 4);
            u32x4 zv[2][4];
#pragma unroll
            for (int ai = 0; ai < 2; ++ai)
#pragma unroll
                for (int m = 0; m < 4; ++m) zv[ai][m] = *(const u32x4*)(z + (size_t)(u.pm * 256 + ai * 128 + wr * 64 + m * 16 + fr) * SSMW + col);
#pragma unroll
            for (int ai = 0; ai < 2; ++ai)
#pragma unroll
                for (int m = 0; m < 4; ++m) {
                    const int row = u.pm * 256 + ai * 128 + wr * 64 + m * 16 + fr;
                    const u32x4 zz = zv[ai][m];
                    const f32x4 a = acc[ai][bj][m][0] + b0, b = acc[ai][bj][m][1] + b1;
                    u32x4 w;
                    w.x = pk2(bflo(zz.x) * sigmoidf_(a[0]), bfhi(zz.x) * sigmoidf_(a[1]));
                    w.y = pk2(bflo(zz.y) * sigmoidf_(a[2]), bfhi(zz.y) * sigmoidf_(a[3]));
                    w.z = pk2(bflo(zz.z) * sigmoidf_(b[0]), bfhi(zz.z) * sigmoidf_(b[1]));
                    w.w = pk2(bflo(zz.w) * sigmoidf_(b[2]), bfhi(zz.w) * sigmoidf_(b[3]));
                    *(u32x4*)(mix + (size_t)row * DM + col) = w;
                }
        }
    }
};

template <bool BASE_X, bool WRITE_HB, int NKS>
__device__ __forceinline__ void sample_finalize(const float* part, unsigned* cnt, int nks, int nsplit_units, const float* xs, float* out, bf16_t* hb, float* ssn, float scale,
                                                int bid, int wave, int lane, int tid, LAS unsigned char* lds) {
    if (bid >= 128) return;
    if (tid == 0) {
        unsigned sp = 0;
        while (__hip_atomic_load(cnt, __ATOMIC_RELAXED, __HIP_MEMORY_SCOPE_AGENT) < (unsigned)nsplit_units) { __builtin_amdgcn_s_sleep(2); if (++sp > (1u << 22)) break; }
        __builtin_amdgcn_fence(__ATOMIC_ACQUIRE, "agent");
        asm volatile("s_waitcnt vmcnt(0)" ::: "memory");
    }
    __syncthreads();
    if (wave < 4) {
        const int r = bid, col = wave * 256 + lane * 4, row = NPROMPT + r;
        f32x4 pv[NKS];
#pragma unroll
        for (int ks = 0; ks < NKS; ++ks) pv[ks] = *(const f32x4*)(part + ((size_t)ks * 128 + r) * DM + col);
        f32x4 s = (f32x4){0.f, 0.f, 0.f, 0.f};
#pragma unroll
        for (int ks = 0; ks < NKS; ++ks) s += pv[ks];
        f32x4 hv; { const u32x2 hw = *(const u32x2*)(hb + (size_t)row * DM + col); hv = (f32x4){bflo(hw.x), bfhi(hw.x), bflo(hw.y), bfhi(hw.y)} + s * scale; }
        if (WRITE_HB) { u32x2 w; w.x = pk2(hv[0], hv[1]); w.y = pk2(hv[2], hv[3]); *(u32x2*)(hb + (size_t)row * DM + col) = w; }
        float sq = (hv[0] * hv[0] + hv[1] * hv[1]) + (hv[2] * hv[2] + hv[3] * hv[3]);
        sq = wave_sum(sq);
        if (lane == 0) atomicAdd(ssn + row, sq);
    }
}

template <int NKS>
__device__ __forceinline__ void sample_finalize_norm(const float* part, unsigned* cnt, int nks, int nsplit_units, float* out, const bf16_t* hb, const float* gamma, float scale,
                                                     int bid, int wave, int lane, int tid, LAS unsigned char* lds) {
    if (bid >= 128) return;
    if (tid == 0) {
        unsigned sp = 0;
        while (__hip_atomic_load(cnt, __ATOMIC_RELAXED, __HIP_MEMORY_SCOPE_AGENT) < (unsigned)nsplit_units) { __builtin_amdgcn_s_sleep(2); if (++sp > (1u << 22)) break; }
        __builtin_amdgcn_fence(__ATOMIC_ACQUIRE, "agent");
        asm volatile("s_waitcnt vmcnt(0)" ::: "memory");
    }
    __syncthreads();
    LAS float* red = (LAS float*)(lds + 131072 + 1024);
    const int r = bid, col = (wave & 3) * 256 + lane * 4, row = NPROMPT + r;
    f32x4 hv = (f32x4){0.f, 0.f, 0.f, 0.f};
    if (wave < 4) {
        f32x4 pv[NKS];
#pragma unroll
        for (int ks = 0; ks < NKS; ++ks) pv[ks] = *(const f32x4*)(part + ((size_t)ks * 128 + r) * DM + col);
        f32x4 s = (f32x4){0.f, 0.f, 0.f, 0.f};
#pragma unroll
        for (int ks = 0; ks < NKS; ++ks) s += pv[ks];
        { const u32x2 hw = *(const u32x2*)(hb + (size_t)row * DM + col); hv = (f32x4){bflo(hw.x), bfhi(hw.x), bflo(hw.y), bfhi(hw.y)} + s * scale; }
        float sq = (hv[0] * hv[0] + hv[1] * hv[1]) + (hv[2] * hv[2] + hv[3] * hv[3]);
        sq = wave_sum(sq);
        if (lane == 0) red[wave] = sq;
    }
    __syncthreads();
    if (wave < 4) {
        const float tot = (red[0] + red[1]) + (red[2] + red[3]);
        const float rs = __builtin_amdgcn_rsqf(tot * (1.0f / DM) + EPS);
        const f32x4 gn = *(const f32x4*)(gamma + col);
        *(f32x4*)(out + (size_t)row * DM + col) = hv * rs * gn;
    }
}

template <int NKS>
__device__ __forceinline__ void sample_finalize_inproj(const float* part, unsigned* cnt, int nsplit_units, const float* ss, bf16_t* p, int bid, int wave, int lane, int tid) {
    if (tid == 0) {
        unsigned sp = 0;
        while (__hip_atomic_load(cnt, __ATOMIC_RELAXED, __HIP_MEMORY_SCOPE_AGENT) < (unsigned)nsplit_units) { __builtin_amdgcn_s_sleep(2); if (++sp > (1u << 22)) break; }
        __builtin_amdgcn_fence(__ATOMIC_ACQUIRE, "agent");
        asm volatile("s_waitcnt vmcnt(0)" ::: "memory");
    }
    __syncthreads();
    const int r = bid * 4 + (wave >> 1), row = NPROMPT + r;
    const float rs = __builtin_amdgcn_rsqf(ss[row] * (1.0f / DM) + EPS);
    if ((wave & 1) == 0) {
        const int col = lane * 16;
        f32x4 pv[NKS][4];
#pragma unroll
        for (int ks = 0; ks < NKS; ++ks)
#pragma unroll
            for (int j = 0; j < 4; ++j) pv[ks][j] = *(const f32x4*)(part + ((size_t)ks * 128 + r) * PW + col + 4 * j);
        u32x4 w[2];
#pragma unroll
        for (int j = 0; j < 4; ++j) {
            f32x4 s = pv[0][j];
#pragma unroll
            for (int ks = 1; ks < NKS; ++ks) s += pv[ks][j];
            s = s * rs;
            w[j >> 1][(j & 1) * 2] = pk2(s[0], s[1]); w[j >> 1][(j & 1) * 2 + 1] = pk2(s[2], s[3]);
        }
        *(u32x4*)(p + (size_t)row * PW + col) = w[0];
        *(u32x4*)(p + (size_t)row * PW + col + 8) = w[1];
    } else {
        const int chn = lane * 8, xcol = 1024 + (chn >> 7) * 256 + (chn & 127);
        f32x4 px[NKS][2], pg[NKS][2];
#pragma unroll
        for (int ks = 0; ks < NKS; ++ks)
#pragma unroll
            for (int j = 0; j < 2; ++j) { px[ks][j] = *(const f32x4*)(part + ((size_t)ks * 128 + r) * PW + xcol + 4 * j); pg[ks][j] = *(const f32x4*)(part + ((size_t)ks * 128 + r) * PW + xcol + 128 + 4 * j); }
        const float r2 = rs * rs;
        u32x4 w;
#pragma unroll
        for (int j = 0; j < 2; ++j) {
            f32x4 sx = px[0][j], sg = pg[0][j];
#pragma unroll
            for (int ks = 1; ks < NKS; ++ks) { sx += px[ks][j]; sg += pg[ks][j]; }
            const f32x4 v = sx * sg * r2;
            w[2 * j] = pk2(v[0], v[1]); w[2 * j + 1] = pk2(v[2], v[3]);
        }
        *(u32x4*)(p + (size_t)row * PW + 1024 + chn) = w;
    }
}

__device__ __forceinline__ void transpose_item(const float* W, int N, int k0, int n0, bf16_t* WT, int K, int drow0, const float* gain, LAS float* scr, int lane) {
    float wv[32];
    const float* wp = W + (size_t)(k0 + (lane >> 5)) * N + n0 + (lane & 31);
#pragma unroll
    for (int i = 0; i < 32; ++i) wv[i] = wp[(size_t)(2 * i) * N];
    const float gsc = gain ? gain[k0 + lane] : 1.0f;
#pragma unroll
    for (int i = 0; i < 32; ++i) { const int kk = 2 * i + (lane >> 5); scr[kk * 33 + (lane & 31)] = wv[i] * __shfl(gsc, kk); }
    LDS_WAIT();
    const int c = lane & 7;
#pragma unroll
    for (int j = 0; j < 4; ++j) { const int n = (lane >> 3) + 8 * j; const LAS float* s = scr + (8 * c) * 33 + n;
        u32x4 o; o.x = pk2(s[0 * 33], s[1 * 33]); o.y = pk2(s[2 * 33], s[3 * 33]); o.z = pk2(s[4 * 33], s[5 * 33]); o.w = pk2(s[6 * 33], s[7 * 33]);
        *(u32x4*)(WT + (size_t)(drow0 + n) * K + k0 + 8 * c) = o; }
    LDS_WAIT();
}
template <int GU>
__device__ __forceinline__ void transpose_matrix(const float* W, int K, int N, bf16_t* WT, const float* gain, LAS float* scr, int lane, int gw, int NGW) {
    const int nblk = N / 32, nitems = (K / 64) * nblk;
    for (int it = gw; it < nitems; it += NGW) {
        const int kb = it / nblk, nb = it % nblk, n0 = nb * 32;
        int drow0;
        if (GU == 0) drow0 = n0;
        else if (GU == 3) {
            const int seg = n0 >> 9, j = n0 & 511;
            drow0 = seg == 0 ? j : seg == 2 ? 512 + j : (4 + (j >> 7)) * 256 + (j & 127) + (seg == 3 ? 128 : 0);
        } else drow0 = 256 * (n0 / 128) + (n0 % 128) + (GU == 2 ? 128 : 0);
        transpose_item(W, N, kb * 64, n0, WT, K, drow0, gain, scr, lane);
    }
}

__device__ __forceinline__ int tau32(int r) { return (r & 3) + 4 * (r >> 3) + 16 * ((r >> 2) & 1); }
constexpr int XS_STRIDE = 272, XS_BYTES = 32 * XS_STRIDE;

template <int MODE>
__device__ __forceinline__ void ssm_item(const Params& P, LAS unsigned char* xs, int lane, int item) {
    unsigned char* ws = P.ws;
    const bf16_t* pb = (const bf16_t*)(ws + WS_P);
    bf16_t* zb = (bf16_t*)(ws + WS_Z);
    const float2* tab_ab = (const float2*)(ws + WS_TAB + T_AB);
    const float2* tab_ab16 = (const float2*)(ws + WS_TAB + T_AB16);
    const float2* tab_ab128 = (const float2*)(ws + WS_TAB + T_AB128);
    float2* Eb = (float2*)(ws + WS_E);
    const int c = lane & 31, h = lane >> 5;
    int g, b = 0, ch = 0, row0, nblk;
    if (MODE == 2) { g = item & 31; const int sb = item >> 5; row0 = NPROMPT + sb * 32; nblk = 1; b = sb * 32; }
    else { g = item & 31; ch = (item >> 5) % NCH; b = item / (32 * NCH); row0 = b * SEQ + ch * TCH; nblk = TCH / 32; }
    const float2 a0 = tab_ab[g * 64 + c], a1 = tab_ab[g * 64 + c + 32];
    bf16x8 bfr[4];
#pragma unroll
    for (int nt = 0; nt < 4; ++nt) bfr[nt] = *(const bf16x8*)(ws + WS_TAB + T_BF + ((size_t)(g * 4 + nt) * 64 + lane) * 16);
    bf16x8 cfr[4];
    f32x4 dsk4 = (f32x4){0.f, 0.f, 0.f, 0.f};
    if (MODE != 0) {
#pragma unroll
        for (int kk = 0; kk < 4; ++kk) cfr[kk] = *(const bf16x8*)(ws + WS_TAB + T_CF + ((size_t)(g * 4 + kk) * 64 + lane) * 16);
        dsk4 = *(const f32x4*)(P.in[18] + g * 16 + 4 * (lane >> 4));
    }
    float X0r = 0.f, X0i = 0.f, X1r = 0.f, X1i = 0.f;
    if (MODE == 1) {
        const float2 p0 = tab_ab128[g * 64 + c], p1 = tab_ab128[g * 64 + c + 32];
        const float2* e0p = Eb + ((size_t)(b * NCH) * 32 + g) * 64 + c;
        for (int cc0 = 0; cc0 < ch; cc0 += 4) {
            float2 e0[4], e1[4];
#pragma unroll
            for (int q = 0; q < 4; ++q) { const int cc = (cc0 + q < ch) ? cc0 + q : ch - 1; e0[q] = e0p[(size_t)cc * 2048]; e1[q] = e0p[(size_t)cc * 2048 + 32]; }
#pragma unroll
            for (int q = 0; q < 4; ++q) if (cc0 + q < ch) {
                const float t0r = p0.x * X0r - p0.y * X0i + e0[q].x, t0i = p0.x * X0i + p0.y * X0r + e0[q].y; X0r = t0r; X0i = t0i;
                const float t1r = p1.x * X1r - p1.y * X1i + e1[q].x, t1i = p1.x * X1i + p1.y * X1r + e1[q].y; X1r = t1r; X1i = t1i;
            }
        }
    }
    const int tok = tau32(c);
    constexpr int NBLK = (MODE == 2) ? 1 : TCH / 32;
    bf16x8 afr[NBLK];
#pragma unroll
    for (int blk = 0; blk < NBLK; ++blk) afr[blk] = *(const bf16x8*)(pb + (size_t)(row0 + blk * 32 + tok) * PW + g * 16 + 8 * h);
#pragma unroll
    for (int blk = 0; blk < NBLK; ++blk) {
        const int rb = row0 + blk * 32;
        const bf16x8 af = afr[blk];
        u32x2 uraw[2];
        if (MODE != 0) {
#pragma unroll
            for (int tb = 0; tb < 2; ++tb) uraw[tb] = *(const u32x2*)(pb + (size_t)(rb + tb * 16 + (lane & 15)) * PW + g * 16 + 4 * (lane >> 4));
        }
        f32x16 D0, D1, D2, D3;
        {
            f32x16 zz;
#pragma unroll
            for (int i = 0; i < 16; ++i) zz[i] = 0.f;
            D0 = __builtin_amdgcn_mfma_f32_32x32x16_bf16(af, bfr[0], zz, 0, 0, 0);
            D1 = __builtin_amdgcn_mfma_f32_32x32x16_bf16(af, bfr[1], zz, 0, 0, 0);
            D2 = __builtin_amdgcn_mfma_f32_32x32x16_bf16(af, bfr[2], zz, 0, 0, 0);
            D3 = __builtin_amdgcn_mfma_f32_32x32x16_bf16(af, bfr[3], zz, 0, 0, 0);
        }
        if (MODE == 2) {
            const float* sre = P.in[2]; const float* sim = P.in[3];
            float* ore = P.out + O_RES; float* oim = P.out + O_IMS;
            float h0r[16], h0i[16], h1r[16], h1i[16];
#pragma unroll
            for (int s = 0; s < 16; ++s) {
                const size_t o = ((size_t)(b + s + 16 * h) * 32 + g) * 64 + c;
                h0r[s] = sre[o]; h0i[s] = sim[o]; h1r[s] = sre[o + 32]; h1i[s] = sim[o + 32];
            }
#pragma unroll
            for (int s = 0; s < 16; ++s) {
                const size_t o = ((size_t)(b + s + 16 * h) * 32 + g) * 64 + c;
                D0[s] += a0.x * h0r[s] - a0.y * h0i[s]; D2[s] += a0.x * h0i[s] + a0.y * h0r[s];
                D1[s] += a1.x * h1r[s] - a1.y * h1i[s]; D3[s] += a1.x * h1i[s] + a1.y * h1r[s];
                ore[o] = D0[s]; oim[o] = D2[s]; ore[o + 32] = D1[s]; oim[o + 32] = D3[s];
            }
        } else {
            float x0r = h ? 0.f : X0r, x0i = h ? 0.f : X0i, x1r = h ? 0.f : X1r, x1i = h ? 0.f : X1i;
#pragma unroll
            for (int s = 0; s < 16; ++s) {
                const float n0r = a0.x * x0r - a0.y * x0i + D0[s], n0i = a0.x * x0i + a0.y * x0r + D2[s];
                const float n1r = a1.x * x1r - a1.y * x1i + D1[s], n1i = a1.x * x1i + a1.y * x1r + D3[s];
                x0r = n0r; x0i = n0i; x1r = n1r; x1i = n1i;
                D0[s] = x0r; D2[s] = x0i; D1[s] = x1r; D3[s] = x1i;
            }
            const float y0r = __shfl(x0r, c), y0i = __shfl(x0i, c), y1r = __shfl(x1r, c), y1i = __shfl(x1i, c);
            if (MODE == 0) {
                const float2 q0 = tab_ab16[g * 64 + c], q1 = tab_ab16[g * 64 + c + 32];
                const float e0r = x0r + q0.x * y0r - q0.y * y0i, e0i = x0i + q0.x * y0i + q0.y * y0r;
                const float e1r = x1r + q1.x * y1r - q1.y * y1i, e1i = x1i + q1.x * y1i + q1.y * y1r;
                X0r = __shfl(e0r, c + 32); X0i = __shfl(e0i, c + 32); X1r = __shfl(e1r, c + 32); X1i = __shfl(e1i, c + 32);
            } else {
                float c0r = h ? y0r : 0.f, c0i = h ? y0i : 0.f, c1r = h ? y1r : 0.f, c1i = h ? y1i : 0.f;
#pragma unroll
                for (int s = 0; s < 16; ++s) {
                    const float n0r = a0.x * c0r - a0.y * c0i, n0i = a0.x * c0i + a0.y * c0r;
                    const float n1r = a1.x * c1r - a1.y * c1i, n1i = a1.x * c1i + a1.y * c1r;
                    c0r = n0r; c0i = n0i; c1r = n1r; c1i = n1i;
                    D0[s] += c0r; D2[s] += c0i; D1[s] += c1r; D3[s] += c1i;
                }
                X0r = __shfl(D0[15], c + 32); X0i = __shfl(D2[15], c + 32); X1r = __shfl(D1[15], c + 32); X1i = __shfl(D3[15], c + 32);
            }
        }
        if (MODE != 0) {
#pragma unroll
            for (int s = 0; s < 16; ++s) {
                u32x2 w; w.x = cvt_pk_bf16(D0[s], D2[s]); w.y = cvt_pk_bf16(D1[s], D3[s]);
                *(LAS u32x2*)(xs + (s + 16 * h) * XS_STRIDE + c * 8) = w;
            }
            LDS_WAIT();
            const int chn = lane & 15, q = lane >> 4;
#pragma unroll
            for (int tb = 0; tb < 2; ++tb) {
                f32x4 y = (f32x4){0.f, 0.f, 0.f, 0.f};
#pragma unroll
                for (int kk = 0; kk < 4; ++kk) {
                    const bf16x8 xa = *(const LAS bf16x8*)(xs + (tb * 16 + chn) * XS_STRIDE + kk * 64 + q * 16);
                    y = __builtin_amdgcn_mfma_f32_16x16x32_bf16(cfr[kk], xa, y, 0, 0, 0);
                }
                {
                    const int row = rb + tb * 16 + chn;
                    const u32x2 uu = uraw[tb];
                    const float z0 = gelu_tanh(y[0] + dsk4[0] * bflo(uu.x)), z1 = gelu_tanh(y[1] + dsk4[1] * bfhi(uu.x));
                    const float z2 = gelu_tanh(y[2] + dsk4[2] * bflo(uu.y)), z3 = gelu_tanh(y[3] + dsk4[3] * bfhi(uu.y));
                    u32x2 w; w.x = cvt_pk_bf16(z0, z1); w.y = cvt_pk_bf16(z2, z3);
                    *(u32x2*)(zb + (size_t)row * SSMW + g * 16 + 4 * q) = w;
                }
            }
            LDS_WAIT();
        }
    }
    if (MODE == 0) {
        if (h == 0) { Eb[((size_t)(b * NCH + ch) * 32 + g) * 64 + c] = make_float2(X0r, X0i); Eb[((size_t)(b * NCH + ch) * 32 + g) * 64 + c + 32] = make_float2(X1r, X1i); }
    }
    if (MODE == 1) {
        if (ch == NCH - 1 && h == 0) {
            float* ore = P.out + O_REP; float* oim = P.out + O_IMP; const size_t o = ((size_t)b * 32 + g) * 64 + c;
            ore[o] = X0r; oim[o] = X0i; ore[o + 32] = X1r; oim[o + 32] = X1i;
        }
    }
}

template <int MODE>
__device__ __forceinline__ void ssm_pair_item(const Params& P, LAS unsigned char* xs, int lane, int item) {
    unsigned char* ws = P.ws;
    const bf16_t* pb = (const bf16_t*)(ws + WS_P);
    bf16_t* zb = (bf16_t*)(ws + WS_Z);
    const float2* tab_ab = (const float2*)(ws + WS_TAB + T_AB);
    const float2* tab_ab128 = (const float2*)(ws + WS_TAB + T_AB128);
    float2* Eb = (float2*)(ws + WS_E);
    const int c = lane & 31, h = lane >> 5;
    const int g = item & 31, ch = (item >> 5) % NCH, bp = item / (32 * NCH);
    const int bh = 2 * bp + h;
    const float2 a0 = tab_ab[g * 64 + c], a1 = tab_ab[g * 64 + c + 32];
    bf16x8 bfr[4];
#pragma unroll
    for (int nt = 0; nt < 4; ++nt) bfr[nt] = *(const bf16x8*)(ws + WS_TAB + T_BF + ((size_t)(g * 4 + nt) * 64 + lane) * 16);
    bf16x8 cfr[4];
    f32x4 dsk4 = (f32x4){0.f, 0.f, 0.f, 0.f};
    if (MODE != 0) {
#pragma unroll
        for (int kk = 0; kk < 4; ++kk) cfr[kk] = *(const bf16x8*)(ws + WS_TAB + T_CF + ((size_t)(g * 4 + kk) * 64 + lane) * 16);
        dsk4 = *(const f32x4*)(P.in[18] + g * 16 + 4 * (lane >> 4));
    }
    float x0r = 0.f, x0i = 0.f, x1r = 0.f, x1i = 0.f;
    if (MODE == 1) {
        const float2 p0 = tab_ab128[g * 64 + c], p1 = tab_ab128[g * 64 + c + 32];
        const float2* e0p = Eb + ((size_t)(bh * NCH) * 32 + g) * 64 + c;
        for (int cc0 = 0; cc0 < ch; cc0 += 4) {
            float2 e0[4], e1[4];
#pragma unroll
            for (int q = 0; q < 4; ++q) { const int cc = (cc0 + q < ch) ? cc0 + q : ch - 1; e0[q] = e0p[(size_t)cc * 2048]; e1[q] = e0p[(size_t)cc * 2048 + 32]; }
#pragma unroll
            for (int q = 0; q < 4; ++q) if (cc0 + q < ch) {
                const float t0r = p0.x * x0r - p0.y * x0i + e0[q].x, t0i = p0.x * x0i + p0.y * x0r + e0[q].y; x0r = t0r; x0i = t0i;
                const float t1r = p1.x * x1r - p1.y * x1i + e1[q].x, t1i = p1.x * x1i + p1.y * x1r + e1[q].y; x1r = t1r; x1i = t1i;
            }
        }
    }
    const int tok = tau32(c);
    const int arow0 = (2 * bp + (tok >> 4)) * SEQ + ch * TCH + (tok & 15);
    constexpr int NSB = TCH / 16;
#pragma unroll 1
    for (int sq4 = 0; sq4 < NSB / 4; ++sq4) {
    bf16x8 afr[4];
#pragma unroll
    for (int s4 = 0; s4 < 4; ++s4) afr[s4] = *(const bf16x8*)(pb + (size_t)(arow0 + (sq4 * 4 + s4) * 16) * PW + g * 16 + 8 * h);
#pragma unroll
    for (int s4 = 0; s4 < 4; ++s4) {
        const int sb = sq4 * 4 + s4;
        const int rb0 = (2 * bp) * SEQ + ch * TCH + sb * 16;
        const bf16x8 af = afr[s4];
        u32x2 uraw[2];
        if (MODE != 0) {
#pragma unroll
            for (int tb = 0; tb < 2; ++tb) uraw[tb] = *(const u32x2*)(pb + (size_t)(rb0 + tb * SEQ + (lane & 15)) * PW + g * 16 + 4 * (lane >> 4));
        }
        f32x16 D0, D1, D2, D3;
        {
            f32x16 zz;
#pragma unroll
            for (int i = 0; i < 16; ++i) zz[i] = 0.f;
            D0 = __builtin_amdgcn_mfma_f32_32x32x16_bf16(af, bfr[0], zz, 0, 0, 0);
            D1 = __builtin_amdgcn_mfma_f32_32x32x16_bf16(af, bfr[1], zz, 0, 0, 0);
            D2 = __builtin_amdgcn_mfma_f32_32x32x16_bf16(af, bfr[2], zz, 0, 0, 0);
            D3 = __builtin_amdgcn_mfma_f32_32x32x16_bf16(af, bfr[3], zz, 0, 0, 0);
        }
#pragma unroll
        for (int s = 0; s < 16; ++s) {
            const float n0r = a0.x * x0r - a0.y * x0i + D0[s], n0i = a0.x * x0i + a0.y * x0r + D2[s];
            const float n1r = a1.x * x1r - a1.y * x1i + D1[s], n1i = a1.x * x1i + a1.y * x1r + D3[s];
            x0r = n0r; x0i = n0i; x1r = n1r; x1i = n1i;
            D0[s] = x0r; D2[s] = x0i; D1[s] = x1r; D3[s] = x1i;
        }
        if (MODE != 0) {
#pragma unroll
            for (int s = 0; s < 16; ++s) {
                u32x2 w; w.x = cvt_pk_bf16(D0[s], D2[s]); w.y = cvt_pk_bf16(D1[s], D3[s]);
                *(LAS u32x2*)(xs + (s + 16 * h) * XS_STRIDE + c * 8) = w;
            }
            LDS_WAIT();
            const int chn = lane & 15, q = lane >> 4;
#pragma unroll
            for (int tb = 0; tb < 2; ++tb) {
                f32x4 y = (f32x4){0.f, 0.f, 0.f, 0.f};
#pragma unroll
                for (int kk = 0; kk < 4; ++kk) {
                    const bf16x8 xa = *(const LAS bf16x8*)(xs + (tb * 16 + chn) * XS_STRIDE + kk * 64 + q * 16);
                    y = __builtin_amdgcn_mfma_f32_16x16x32_bf16(cfr[kk], xa, y, 0, 0, 0);
                }
                {
                    const int row = rb0 + tb * SEQ + chn;
                    const u32x2 uu = uraw[tb];
                    const float z0 = gelu_tanh(y[0] + dsk4[0] * bflo(uu.x)), z1 = gelu_tanh(y[1] + dsk4[1] * bfhi(uu.x));
                    const float z2 = gelu_tanh(y[2] + dsk4[2] * bflo(uu.y)), z3 = gelu_tanh(y[3] + dsk4[3] * bfhi(uu.y));
                    u32x2 w; w.x = cvt_pk_bf16(z0, z1); w.y = cvt_pk_bf16(z2, z3);
                    *(u32x2*)(zb + (size_t)row * SSMW + g * 16 + 4 * q) = w;
                }
            }
            LDS_WAIT();
        }
        __builtin_amdgcn_sched_barrier(0);
    }
    }
    if (MODE == 0) {
        Eb[((size_t)(bh * NCH + ch) * 32 + g) * 64 + c] = make_float2(x0r, x0i); Eb[((size_t)(bh * NCH + ch) * 32 + g) * 64 + c + 32] = make_float2(x1r, x1i);
    }
    if (MODE == 1) {
        if (ch == NCH - 1) {
            float* ore = P.out + O_REP; float* oim = P.out + O_IMP; const size_t o = ((size_t)bh * 32 + g) * 64 + c;
            ore[o] = x0r; oim[o] = x0i; ore[o + 32] = x1r; oim[o + 32] = x1i;
        }
    }
}

__device__ __forceinline__ void conv_items(const Params& P, int it0, int it1, int stride) {
    unsigned char* ws = P.ws;
    const bf16_t* pbuf = (const bf16_t*)(ws + WS_P);
    bf16_t* mix = (bf16_t*)(ws + WS_MIX);
    const float* cw = P.in[21]; const float* scv = P.in[4];
        for (int it = it0; it < it1; it += stride) {
            const int row = it >> 6, c8 = (it & 63) * 8;
            const bf16_t* pr = pbuf + (size_t)row * PW;
            const u32x4 vc = *(const u32x4*)(pr + 1024 + c8), gb = *(const u32x4*)(pr + 512 + c8);
            float v0[8], v1[8], v2[8], gbf[8];
#pragma unroll
            for (int q = 0; q < 4; ++q) { v0[2 * q] = bflo(vc[q]); v0[2 * q + 1] = bfhi(vc[q]); gbf[2 * q] = bflo(gb[q]); gbf[2 * q + 1] = bfhi(gb[q]); }
            if (row < NPROMPT) {
                const int t = row & (SEQ - 1);
                if (t >= 1) { const u32x4 x1 = *(const u32x4*)(pr - PW + 1024 + c8);
#pragma unroll
                    for (int q = 0; q < 4; ++q) { v1[2 * q] = bflo(x1[q]); v1[2 * q + 1] = bfhi(x1[q]); } }
                else {
#pragma unroll
                    for (int q = 0; q < 8; ++q) v1[q] = 0.f; }
                if (t >= 2) { const u32x4 x2 = *(const u32x4*)(pr - 2 * PW + 1024 + c8);
#pragma unroll
                    for (int q = 0; q < 4; ++q) { v2[2 * q] = bflo(x2[q]); v2[2 * q + 1] = bfhi(x2[q]); } }
                else {
#pragma unroll
                    for (int q = 0; q < 8; ++q) v2[q] = 0.f; }
                if (t == SEQ - 1) { float* o = P.out + O_CVP + (size_t)(row >> 11) * 1024 + c8;
#pragma unroll
                    for (int q = 0; q < 8; ++q) { o[q] = v1[q]; o[512 + q] = v0[q]; } }
            } else {
                const int sb = row - NPROMPT; const float* bf = scv + (size_t)sb * 1024 + c8;
#pragma unroll
                for (int q = 0; q < 8; ++q) { v2[q] = bf[q]; v1[q] = bf[512 + q]; }
                float* o = P.out + O_CVS + (size_t)sb * 1024 + c8;
#pragma unroll
                for (int q = 0; q < 8; ++q) { o[q] = v1[q]; o[512 + q] = v0[q]; }
            }
            float co[8];
#pragma unroll
            for (int q = 0; q < 8; ++q) co[q] = gbf[q] * (cw[c8 + q] * v2[q] + cw[512 + c8 + q] * v1[q] + cw[1024 + c8 + q] * v0[q]);
            u32x4 w; w.x = pk2(co[0], co[1]); w.y = pk2(co[2], co[3]); w.z = pk2(co[4], co[5]); w.w = pk2(co[6], co[7]);
            *(u32x4*)(mix + (size_t)row * DM + 512 + c8) = w;
        }
}

__device__ __forceinline__ void conv_prompt_quads(const Params& P, int q0, int q1, int stride) {
    unsigned char* ws = P.ws;
    const bf16_t* pbuf = (const bf16_t*)(ws + WS_P);
    bf16_t* mix = (bf16_t*)(ws + WS_MIX);
    const float* cw = P.in[21];
    for (int qi = q0; qi < q1; qi += stride) {
        const int row = (qi >> 6) * 4, c8 = (qi & 63) * 8, t0 = row & (SEQ - 1);
        const bf16_t* pr = pbuf + (size_t)row * PW;
        const bf16_t* prm = t0 ? pr : pr + 2 * PW;
        u32x4 vv[6], gb[4];
        vv[0] = *(const u32x4*)(prm - 2 * PW + 1024 + c8); vv[1] = *(const u32x4*)(prm - PW + 1024 + c8);
#pragma unroll
        for (int r = 0; r < 4; ++r) { vv[2 + r] = *(const u32x4*)(pr + (size_t)r * PW + 1024 + c8); gb[r] = *(const u32x4*)(pr + (size_t)r * PW + 512 + c8); }
        float w0[8], w1[8], w2[8];
#pragma unroll
        for (int q = 0; q < 8; ++q) { w0[q] = cw[c8 + q]; w1[q] = cw[512 + c8 + q]; w2[q] = cw[1024 + c8 + q]; }
        float vf[6][8];
#pragma unroll
        for (int r = 0; r < 6; ++r)
#pragma unroll
            for (int q = 0; q < 4; ++q) { vf[r][2 * q] = bflo(vv[r][q]); vf[r][2 * q + 1] = bfhi(vv[r][q]); }
        if (t0 == 0) {
#pragma unroll
            for (int q = 0; q < 8; ++q) { vf[0][q] = 0.f; vf[1][q] = 0.f; }
        }
#pragma unroll
        for (int r = 0; r < 4; ++r) {
            float co[8];
#pragma unroll
            for (int q = 0; q < 4; ++q) {
                co[2 * q] = bflo(gb[r][q]) * (w0[2 * q] * vf[r][2 * q] + w1[2 * q] * vf[r + 1][2 * q] + w2[2 * q] * vf[r + 2][2 * q]);
                co[2 * q + 1] = bfhi(gb[r][q]) * (w0[2 * q + 1] * vf[r][2 * q + 1] + w1[2 * q + 1] * vf[r + 1][2 * q + 1] + w2[2 * q + 1] * vf[r + 2][2 * q + 1]);
            }
            u32x4 w; w.x = pk2(co[0], co[1]); w.y = pk2(co[2], co[3]); w.z = pk2(co[4], co[5]); w.w = pk2(co[6], co[7]);
            *(u32x4*)(mix + (size_t)(row + r) * DM + 512 + c8) = w;
        }
        if (t0 == SEQ - 4) {
            float* o = P.out + O_CVP + (size_t)(row >> 11) * 1024 + c8;
#pragma unroll
            for (int q = 0; q < 8; ++q) { o[q] = vf[4][q]; o[512 + q] = vf[5][q]; }
        }
    }
}

typedef __attribute__((address_space(1))) unsigned gu32;
#define XB_TMO      128
#define XB_XCNT(j)  (256  + 64 * (j))
#define XB_XSUB(j)  (1280 + 64 * (j))
#define XB_XGEN(j)  (2304 + 64 * (j))
#define XB_TOP      3328
#define XB_TOPGEN   3392
#define XCD_BAR_WORDS 3456
#define XB_SPIN_CAP (1u << 18)

__device__ __forceinline__ unsigned xb_ld(unsigned* p)              { return __hip_atomic_load(p, __ATOMIC_RELAXED, __HIP_MEMORY_SCOPE_AGENT); }
__device__ __forceinline__ unsigned xb_add(unsigned* p, unsigned v) { return __hip_atomic_fetch_add(p, v, __ATOMIC_RELAXED, __HIP_MEMORY_SCOPE_AGENT); }
__device__ __forceinline__ unsigned xb_xcc_id() { return (unsigned)__builtin_amdgcn_s_getreg((3 << 11) | 20) & 0xFu; }
#define XB_SPIN(cond, bar) do { unsigned _sp = 0; while (cond) { __builtin_amdgcn_s_sleep(1); \
    if ((++_sp & 255u) == 0u) { if (xb_ld(&(bar)[XB_TMO])) break; if (_sp > XB_SPIN_CAP) { atomicAdd(&(bar)[XB_TMO], 1u); break; } } } } while (0)

struct XcdBarrier {
    unsigned* bar; unsigned x;
    volatile LAS unsigned* st;
};

__device__ __forceinline__ XcdBarrier xcd_barrier_post(unsigned* bar, volatile LAS unsigned* st) {
    XcdBarrier b; b.bar = bar; b.x = xb_xcc_id(); b.st = st;
    if (threadIdx.x == 0) (void)xb_add(&bar[XB_XCNT(b.x)], 1u);
    return b;
}
__device__ __forceinline__ void xcd_barrier_complete(unsigned* bar, unsigned x, unsigned& nloc, unsigned& nx) {
    const unsigned G = gridDim.x * gridDim.y * gridDim.z;
    unsigned sum, cnt, mine, sp = 0u;
    for (;;) {
        sum = 0u; cnt = 0u; mine = 0u;
#pragma unroll
        for (unsigned j = 0; j < 16; ++j) { const unsigned c = xb_ld(&bar[XB_XCNT(j)]); sum += c; cnt += (c > 0u) ? 1u : 0u; mine = (j == x) ? c : mine; }
        if (sum == G) break;
        __builtin_amdgcn_s_sleep(1);
        if ((++sp & 255u) == 0u) { if (xb_ld(&bar[XB_TMO])) break; if (sp > XB_SPIN_CAP) { atomicAdd(&bar[XB_TMO], 1u); break; } }
    }
    nloc = mine > 0u ? mine : 1u; nx = cnt > 0u ? cnt : 1u;
}

__device__ __forceinline__ void xcd_barrier(const XcdBarrier& b) {
    asm volatile("s_waitcnt vmcnt(0)" ::: "memory");
    __syncthreads();
    if (threadIdx.x == 0) {
        unsigned* bar = b.bar;
        __builtin_amdgcn_s_waitcnt(0);
        unsigned nloc = b.st[0], nx = b.st[1];
        if (nloc == 0u) { xcd_barrier_complete(bar, b.x, nloc, nx); b.st[0] = nloc; b.st[1] = nx; }
        const unsigned old = xb_add(&bar[XB_XSUB(b.x)], 1u);
        const unsigned gen = old / nloc;
        if (old + 1u == (gen + 1u) * nloc) {
            __builtin_amdgcn_fence(__ATOMIC_RELEASE, "agent");
            asm volatile("s_waitcnt vmcnt(0)" ::: "memory");
            const unsigned og = xb_add(&bar[XB_TOP], 1u);
            const unsigned tg = og / nx;
            if (og + 1u == (tg + 1u) * nx) xb_add(&bar[XB_TOPGEN], 1u);
            else XB_SPIN(xb_ld(&bar[XB_TOPGEN]) == tg, bar);
            __builtin_amdgcn_fence(__ATOMIC_ACQUIRE, "agent");
            xb_add(&bar[XB_XGEN(b.x)], 1u);
            asm volatile("s_waitcnt vmcnt(0)" ::: "memory");
        } else {
            XB_SPIN(xb_ld(&bar[XB_XGEN(b.x)]) == gen, bar);
            __builtin_amdgcn_fence(__ATOMIC_ACQUIRE, "agent");
            asm volatile("s_waitcnt vmcnt(0)" ::: "memory");
        }
    }
    __syncthreads();
}


__global__ void __launch_bounds__(NTHREADS, 2) hymba_fwd(Params P) {
    extern __shared__ __attribute__((aligned(16))) unsigned char lds_raw[];
    LAS unsigned char* lds = (LAS unsigned char*)lds_raw;
    cg::grid_group grid = cg::this_grid();
    const int tid = threadIdx.x, lane = tid & 63, wave = __builtin_amdgcn_readfirstlane(tid >> 6);
    const int G = gridDim.x, bid = blockIdx.x;
    const int gw = bid * NWAVES + wave, NGW = G * NWAVES;
    unsigned char* ws = P.ws;
    float* ss = (float*)(ws + WS_SS);
    bf16_t* ab = (bf16_t*)(ws + WS_AB);
    bf16_t* act = (bf16_t*)(ws + WS_ACT);
    bf16_t* pbuf = (bf16_t*)(ws + WS_P);
    bf16_t* zbuf = (bf16_t*)(ws + WS_Z);
    bf16_t* mix = (bf16_t*)(ws + WS_MIX);
    const float* xp = P.in[0]; const float* xsamp = P.in[1];
    volatile LAS unsigned* bst = (volatile LAS unsigned*)(lds + 131072 + 512);
    if (tid < 2) bst[tid] = 0u;
    __syncthreads();
    XcdBarrier xbar = xcd_barrier_post((unsigned*)(ws + WS_BAR), bst);

    {
        LAS float* scr = (LAS float*)(lds + wave * 16384);
        transpose_matrix<1>(P.in[6], DM, DFF, (bf16_t*)(ws + WS_WGU1), P.in[5], scr, lane, gw, NGW);
        transpose_matrix<2>(P.in[7], DM, DFF, (bf16_t*)(ws + WS_WGU1), P.in[5], scr, lane, gw, NGW);
        for (int row0 = gw; row0 < MROWS; row0 += 2 * NGW) {
            const int row1 = row0 + NGW; const bool has1 = row1 < MROWS; const int r1c = has1 ? row1 : row0;
            const float* xr0 = row0 < NPROMPT ? xp + (size_t)row0 * DM : xsamp + (size_t)(row0 - NPROMPT) * DM;
            const float* xr1 = r1c < NPROMPT ? xp + (size_t)r1c * DM : xsamp + (size_t)(r1c - NPROMPT) * DM;
            f32x4 v0[4], v1[4];
#pragma unroll
            for (int j = 0; j < 4; ++j) { v0[j] = *(const f32x4*)(xr0 + j * 256 + lane * 4); v1[j] = *(const f32x4*)(xr1 + j * 256 + lane * 4); }
            float s0 = 0.f, s1 = 0.f;
#pragma unroll
            for (int j = 0; j < 4; ++j) {
                s0 += (v0[j][0] * v0[j][0] + v0[j][1] * v0[j][1]) + (v0[j][2] * v0[j][2] + v0[j][3] * v0[j][3]);
                s1 += (v1[j][0] * v1[j][0] + v1[j][1] * v1[j][1]) + (v1[j][2] * v1[j][2] + v1[j][3] * v1[j][3]);
                u32x2 w; w.x = cvt_pk_bf16(v0[j][0], v0[j][1]); w.y = cvt_pk_bf16(v0[j][2], v0[j][3]);
                *(u32x2*)(ab + (size_t)row0 * DM + j * 256 + lane * 4) = w;
                if (has1) { u32x2 w1; w1.x = cvt_pk_bf16(v1[j][0], v1[j][1]); w1.y = cvt_pk_bf16(v1[j][2], v1[j][3]); *(u32x2*)(ab + (size_t)row1 * DM + j * 256 + lane * 4) = w1; }
            }
            s0 = wave_sum(s0); s1 = wave_sum(s1);
            if (lane == 0) { ss[row0] = s0; if (has1) ss[row1] = s1; }
        }
        for (int i = bid * NTHREADS + tid; i < 3 * MP; i += G * NTHREADS) ss[MP + i] = 0.f;
        for (int i = bid * NTHREADS + tid; i < MP - MROWS; i += G * NTHREADS) ss[MROWS + i] = 1024.f;
        if (bid == 0 && tid < 256) ((unsigned*)(ws + WS_CNT))[tid] = 0u;
        {
            float2* t_ab = (float2*)(ws + WS_TAB + T_AB); float2* t_ab16 = (float2*)(ws + WS_TAB + T_AB16); float2* t_ab128 = (float2*)(ws + WS_TAB + T_AB128);
            const float* lre = P.in[11]; const float* lim = P.in[12]; const float* ldt = P.in[13];
            for (int i = bid * NTHREADS + tid; i < NG * NS; i += G * NTHREADS) {
                const int g = i >> 6;
                const float dt = expf(ldt[g]); const float lr = lre[i], li = lim[i];
                const float mag = expf(lr * dt); const float th = li * dt;
                float ar = mag * cosf(th), ai = mag * sinf(th);
                t_ab[i] = make_float2(ar, ai);
                float pr = ar, pi = ai;
#pragma unroll
                for (int k = 0; k < 7; ++k) { const float nr = pr * pr - pi * pi, ni = 2.f * pr * pi; pr = nr; pi = ni; if (k == 3) t_ab16[i] = make_float2(pr, pi); }
                t_ab128[i] = make_float2(pr, pi);
            }
            bf16_t* t_bf = (bf16_t*)(ws + WS_TAB + T_BF); bf16_t* t_cf = (bf16_t*)(ws + WS_TAB + T_CF);
            const float* bre = P.in[14]; const float* bim = P.in[15]; const float* cre = P.in[16]; const float* cim = P.in[17];
            for (int i = bid * NTHREADS + tid; i < NG * 4 * 64 * 8; i += G * NTHREADS) {
                const int j = i & 7, ln = (i >> 3) & 63, nt = (i >> 9) & 3, g = i >> 11;
                {
                    const int st = (nt & 1) * 32 + (ln & 31), part = nt >> 1, chn = 8 * (ln >> 5) + j;
                    const int gi = g * 64 + st;
                    const float dt = expf(ldt[g]); const float lr = lre[gi], li = lim[gi];
                    const float mag = expf(lr * dt); const float th = li * dt;
                    const float ar = mag * cosf(th), ai = mag * sinf(th);
                    const float den = lr * lr + li * li, nr = ar - 1.0f, ni = ai;
                    const float cr = (nr * lr + ni * li) / den, ci = (ni * lr - nr * li) / den;
                    const float br = bre[(size_t)gi * 16 + chn], bi = bim[(size_t)gi * 16 + chn];
                    const float v = part == 0 ? (cr * br - ci * bi) : (cr * bi + ci * br);
                    t_bf[i] = (bf16_t)f2bf(v);
                }
                {
                    const int kk = nt, k = kk * 32 + 8 * (ln >> 4) + j, chn = ln & 15, cc = k >> 2, sel = k & 3;
                    const int st = cc + ((sel >> 1) ? 32 : 0);
                    const size_t ci_ = ((size_t)g * 16 + chn) * 64 + st;
                    const float v = (sel & 1) ? -cim[ci_] : cre[ci_];
                    t_cf[i] = (bf16_t)f2bf(v);
                }
            }
        }
    }
    if (gridDim.y == 7) grid.sync();
    xcd_barrier(xbar);

    {
        pg8::Gemm g{ab, (const bf16_t*)(ws + WS_WGU1), MP, 2 * DFF, DM}; pg8::SplitOrder S; S.init(2 * DFF, DM, 1, G, bid);
        EpiGateUp E{act, ss};
        pg8::gemm_phase<EpiGateUp, pg8::SplitOrder, true, true>(lds, g, S, E, pg8::SplitCtx{nullptr, nullptr, 1});
        const int first_idle = (65 * 22) % G;
        if (bid >= first_idle) {
            LAS float* scr = (LAS float*)(lds + wave * 16384);
            const int w2 = (bid - first_idle) * NWAVES + wave, NW2 = (G - first_idle) * NWAVES;
            transpose_matrix<0>(P.in[8], DFF, DM, (bf16_t*)(ws + WS_WD1), nullptr, scr, lane, w2, NW2);
            transpose_matrix<3>(P.in[10], DM, PW, (bf16_t*)(ws + WS_WIN), P.in[9], scr, lane, w2, NW2);
            transpose_matrix<0>(P.in[19], SSMW, SSMW, (bf16_t*)(ws + WS_WGLU), nullptr, scr, lane, w2, NW2);
            transpose_matrix<0>(P.in[22], DM, DM, (bf16_t*)(ws + WS_WOUT), nullptr, scr, lane, w2, NW2);
        }
    }
    xcd_barrier(xbar);
    {
        pg8::Gemm g{act, (const bf16_t*)(ws + WS_WD1), MP, DM, DFF}; pg8::SplitOrder S; S.init(DM, DFF, 22, G, bid);
        EpiResid<false> E{xp, xsamp, ab, ss + MP, 0.5f};
        pg8::gemm_phase<EpiResid<false>, pg8::SplitOrder, true, true>(lds, g, S, E, pg8::SplitCtx{(float*)(ws + WS_PART), (unsigned*)(ws + WS_CNT), 22});
        sample_finalize<true, true, 22>((const float*)(ws + WS_PART), (unsigned*)(ws + WS_CNT), 22, 88, xsamp, P.out, ab, ss + MP, 0.5f, bid, wave, lane, tid, lds);
    }
    xcd_barrier(xbar);
    {
        pg8::Gemm g{ab, (const bf16_t*)(ws + WS_WIN), MP, PW, DM}; pg8::SplitOrder S; S.init(PW, DM, 1, G, bid, 1);
        EpiInProj E{pbuf, ss + MP};
        pg8::gemm_phase<EpiInProj, pg8::SplitOrder, true, true>(lds, g, S, E, pg8::SplitCtx{nullptr, nullptr, 1});
    }
    xcd_barrier(xbar);
    if (bid < 32) {
        pg8::Gemm g{ab, (const bf16_t*)(ws + WS_WIN), MP, PW, DM}; pg8::SplitOrder S; S.init(PW, DM, 4, G, bid, 2);
        EpiPartOnly E{};
        pg8::gemm_phase<EpiPartOnly, pg8::SplitOrder, true, true>(lds, g, S, E, pg8::SplitCtx{(float*)(ws + WS_PART), (unsigned*)(ws + WS_CNT) + 192, 4});
        sample_finalize_inproj<4>((const float*)(ws + WS_PART), (unsigned*)(ws + WS_CNT) + 192, 32, ss + MP, pbuf, bid, wave, lane, tid);
    } else {
        LAS unsigned char* xs = lds + wave * XS_BYTES;
        const int gw4 = (bid - 32) * NWAVES + wave, NGW4 = (G - 32) * NWAVES;
        for (int it = gw4; it < NBATCH * NCH * 32; it += NGW4) { if (((it >> 5) % NCH) != NCH - 1) ssm_item<0>(P, xs, lane, it); }
        conv_prompt_quads(P, (bid - 32) * NTHREADS + tid, (NPROMPT / 4) * 64, (G - 32) * NTHREADS);
    }
    xcd_barrier(xbar);
    {
        LAS unsigned char* xs = lds + wave * XS_BYTES;
        for (int it = gw; it < (NBATCH / 2) * NCH * 32 + (NSAMP / 32) * 32; it += NGW) {
            if (it < (NBATCH / 2) * NCH * 32) ssm_pair_item<1>(P, xs, lane, it); else ssm_item<2>(P, xs, lane, it - (NBATCH / 2) * NCH * 32);
        }
        conv_items(P, NPROMPT * 64 + bid * NTHREADS + tid, MROWS * 64, G * NTHREADS);
    }
    xcd_barrier(xbar);
    {
        pg8::Gemm g{zbuf, (const bf16_t*)(ws + WS_WGLU), MP, SSMW, SSMW}; pg8::SplitOrder S; S.init(SSMW, SSMW, 1, G, bid);
        EpiGlu E{zbuf, P.in[20], mix};
        pg8::gemm_phase<EpiGlu, pg8::SplitOrder, true, true>(lds, g, S, E, pg8::SplitCtx{nullptr, nullptr, 1});
        const int first_idle = (65 * 2) % G;
        if (bid >= first_idle) {
            LAS float* scr = (LAS float*)(lds + wave * 16384);
            const int w2 = (bid - first_idle) * NWAVES + wave, NW2 = (G - first_idle) * NWAVES;
            transpose_matrix<1>(P.in[24], DM, DFF, (bf16_t*)(ws + WS_WGU2), P.in[23], scr, lane, w2, NW2);
            transpose_matrix<2>(P.in[25], DM, DFF, (bf16_t*)(ws + WS_WGU2), P.in[23], scr, lane, w2, NW2);
        }
    }
    xcd_barrier(xbar);
    {
        pg8::Gemm g{mix, (const bf16_t*)(ws + WS_WOUT), MP, DM, DM}; pg8::SplitOrder S; S.init(DM, DM, 8, G, bid);
        EpiResid<false> E{xp, xsamp, ab, ss + 2 * MP, 1.0f};
        pg8::gemm_phase<EpiResid<false>, pg8::SplitOrder, true, true>(lds, g, S, E, pg8::SplitCtx{(float*)(ws + WS_PART), (unsigned*)(ws + WS_CNT) + 160, 8});
        sample_finalize<true, true, 8>((const float*)(ws + WS_PART), (unsigned*)(ws + WS_CNT) + 160, 8, 32, xsamp, P.out, ab, ss + 2 * MP, 1.0f, bid, wave, lane, tid, lds);
    }
    xcd_barrier(xbar);
    {
        pg8::Gemm g{ab, (const bf16_t*)(ws + WS_WGU2), MP, 2 * DFF, DM}; pg8::SplitOrder S; S.init(2 * DFF, DM, 1, G, bid);
        EpiGateUp E{act, ss + 2 * MP};
        pg8::gemm_phase<EpiGateUp, pg8::SplitOrder, true, true>(lds, g, S, E, pg8::SplitCtx{nullptr, nullptr, 1});
        const int first_idle = (65 * 22) % G;
        if (bid >= first_idle) {
            LAS float* scr = (LAS float*)(lds + wave * 16384);
            const int w2 = (bid - first_idle) * NWAVES + wave, NW2 = (G - first_idle) * NWAVES;
            transpose_matrix<0>(P.in[26], DFF, DM, (bf16_t*)(ws + WS_WD2), nullptr, scr, lane, w2, NW2);
        }
    }
    xcd_barrier(xbar);
    {
        pg8::Gemm g{act, (const bf16_t*)(ws + WS_WD2), MP, DM, DFF}; pg8::SplitOrder S; S.init(DM, DFF, 22, G, bid);
        EpiFinal E{P.out, ab, ss + 3 * MP, (unsigned*)(ws + WS_CNT) + 64, P.in[27], 0.5f};
        pg8::gemm_phase<EpiFinal, pg8::SplitOrder, true, true>(lds, g, S, E, pg8::SplitCtx{(float*)(ws + WS_PART), (unsigned*)(ws + WS_CNT) + 32, 22});
        sample_finalize_norm<22>((const float*)(ws + WS_PART), (unsigned*)(ws + WS_CNT) + 32, 22, 88, P.out, ab, P.in[27], 0.5f, bid, wave, lane, tid, lds);
    }
}

extern "C" void kernel_launch(void* const* d_in, const int* in_sizes, int n_in, void* d_out, int out_size, void* d_ws, size_t ws_size, hipStream_t stream) {
    static int grid_blocks = 0;
    if (grid_blocks == 0) {
        if (n_in != 28 || ws_size < WS_END) { fprintf(stderr, "kernel_launch: unexpected n_in %d / ws %zu\n", n_in, ws_size); grid_blocks = -1; return; }
        int dev = 0, cus = 0, per_cu = 0;
        hipGetDevice(&dev);
        hipDeviceGetAttribute(&cus, hipDeviceAttributeMultiprocessorCount, dev);
        if (hipFuncSetAttribute((const void*)hymba_fwd, hipFuncAttributeMaxDynamicSharedMemorySize, LDS_BYTES) != hipSuccess) { fprintf(stderr, "kernel_launch: hipFuncSetAttribute failed\n"); grid_blocks = -1; return; }
        if (hipOccupancyMaxActiveBlocksPerMultiprocessor(&per_cu, (const void*)hymba_fwd, NTHREADS, LDS_BYTES) != hipSuccess || per_cu < 1) { fprintf(stderr, "kernel_launch: occupancy query gave %d\n", per_cu); per_cu = 1; }
        (void)hipGetLastError();
        grid_blocks = cus * 1;
        fprintf(stderr, "kernel_launch: cus %d per_cu %d grid %d\n", cus, per_cu, grid_blocks);
    }
    if (grid_blocks < 0) return;
    Params p{};
    for (int i = 0; i < 28; ++i) p.in[i] = (const float*)d_in[i];
    p.out = (float*)d_out; p.ws = (unsigned char*)d_ws;
    if (hipMemsetAsync((char*)d_ws + WS_BAR, 0, 16384, stream) != hipSuccess) { fprintf(stderr, "kernel_launch: memset failed\n"); return; }
    void* args[] = {&p};
    hipError_t e = hipLaunchCooperativeKernel((const void*)hymba_fwd, dim3(grid_blocks), dim3(NTHREADS), args, LDS_BYTES, stream);
    if (e != hipSuccess) fprintf(stderr, "cooperative launch failed: %s (grid %d)\n", hipGetErrorString(e), grid_blocks);
}
```

```cpp
#include <hip/hip_runtime.h>
#include <hip/hip_cooperative_groups.h>
#include <cstdio>
#include <cstdint>
namespace cg = cooperative_groups;

#define LAS __attribute__((address_space(3)))
typedef unsigned short bf16_t;
typedef short bf16x8 __attribute__((ext_vector_type(8)));
typedef float f32x4 __attribute__((ext_vector_type(4)));
typedef float f32x16 __attribute__((ext_vector_type(16)));
typedef unsigned u32x4 __attribute__((ext_vector_type(4)));
typedef unsigned u32x2 __attribute__((ext_vector_type(2)));

constexpr int DM = 1024, NPROMPT = 16384, NSAMP = 128, MROWS = NPROMPT + NSAMP, MP = 16640, DFF = 2816, SEQ = 2048, NBATCH = 8;
constexpr int NG = 32, NS = 64, PW = 2048, SSMW = 512;
constexpr int TCH = 128, NCH = SEQ / TCH;
constexpr float EPS = 1e-6f;
constexpr int NWAVES = 8, NTHREADS = 512;
constexpr int LDS_BYTES = 147456;

constexpr size_t O_REP = (size_t)MROWS * DM, O_IMP = O_REP + 16384, O_CVP = O_IMP + 16384, O_RES = O_CVP + 8192, O_IMS = O_RES + 262144, O_CVS = O_IMS + 262144;

constexpr size_t MiB = 1u << 20;
constexpr size_t WS_SS = 0;
constexpr size_t WS_TAB = 1 * MiB;
constexpr size_t T_AB = 0, T_AB16 = 16384, T_AB128 = 32768, T_BF = 49152, T_CF = T_BF + 131072;
constexpr size_t WS_WGU1 = 4 * MiB, WS_WD1 = WS_WGU1 + 11 * MiB, WS_WIN = WS_WD1 + 5632 * 1024, WS_WGLU = WS_WIN + 4 * MiB, WS_WOUT = WS_WGLU + 512 * 1024,
                 WS_WGU2 = WS_WOUT + 2 * MiB, WS_WD2 = WS_WGU2 + 11 * MiB;
constexpr size_t WS_AB = 44 * MiB;
constexpr size_t WS_ACT = 77 * MiB;
constexpr size_t WS_P = WS_ACT, WS_Z = WS_ACT + 65 * MiB;
constexpr size_t WS_MIX = 167 * MiB;
constexpr size_t WS_E = 200 * MiB;
constexpr size_t WS_PART = 202 * MiB;
constexpr size_t WS_BAR = 768 * 1024;
constexpr size_t WS_CNT = 512 * 1024;
constexpr size_t WS_END = 214 * MiB;

struct Params { const float* in[28]; float* out; unsigned char* ws; };

__device__ __forceinline__ unsigned f2bf(float f) { unsigned u = __builtin_bit_cast(unsigned, f); return (u + 0x7fffu + ((u >> 16) & 1u)) >> 16; }
__device__ __forceinline__ unsigned cvt_pk_bf16(float lo, float hi) { unsigned r; asm("v_cvt_pk_bf16_f32 %0, %1, %2" : "=v"(r) : "v"(lo), "v"(hi)); return r; }
__device__ __forceinline__ unsigned pk2(float lo, float hi) { return cvt_pk_bf16(lo, hi); }
__device__ __forceinline__ float bf2f(unsigned short b) { return __builtin_bit_cast(float, (unsigned)b << 16); }
__device__ __forceinline__ float bflo(unsigned w) { return __builtin_bit_cast(float, w << 16); }
__device__ __forceinline__ float bfhi(unsigned w) { return __builtin_bit_cast(float, w & 0xffff0000u); }
__device__ __forceinline__ float sigmoidf_(float x) { return __builtin_amdgcn_rcpf(1.0f + __builtin_amdgcn_exp2f(-1.4426950408889634f * x)); }
__device__ __forceinline__ float gelu_tanh(float y) { const float v = 0.7978845608028654f * (y + 0.044715f * y * y * y); return y * __builtin_amdgcn_rcpf(1.0f + __builtin_amdgcn_exp2f(-2.8853900817779268f * v)); }
__device__ __forceinline__ float wave_sum(float v) {
#pragma unroll
    for (int o = 1; o < 64; o <<= 1) v += __shfl_xor(v, o);
    return v;
}
#define LDS_WAIT() asm volatile("s_waitcnt lgkmcnt(0)" ::: "memory")

namespace pg8 {
constexpr int BM = 256, BK = 64, HALF = 128, HTB = HALF * BK * 2, STAGE_BYTES = 8 * HTB, NXCD = 8, WGM = 8;
__host__ __device__ __forceinline__ int lds_byte(int r, int c) { const int st = (r >> 4) * 2 + (c >> 5), rr = r & 15, cc = c & 31, ob = rr * 64 + cc * 2; return st * 1024 + (ob ^ (((ob >> 9) & 1) << 5)); }
__host__ __device__ __forceinline__ void stage_rc(int b, int& R, int& C) { const int st = b / 1024, sb = b % 1024, swz = sb ^ (((sb >> 9) & 1) << 5); R = (st >> 1) * 16 + swz / 64; C = (st & 1) * 32 + (swz % 64) / 2; }
__host__ __device__ __forceinline__ int perm32(int rho) { const int n = rho >> 4, i = rho & 15; return 8 * (i >> 2) + 4 * n + (i & 3); }
struct Unit { int pm, pn, k0, nt, split; };
struct Gemm { const bf16_t* A; const bf16_t* Bt; int M, N, K; };
struct SplitOrder {
    int nN, nwgp, nks, ntk, ntf, G, c, which;
    __device__ void init(int N, int K, int nks_, int G_, int c_, int which_ = 0) { nN = N / BM; nwgp = 64 * nN; nks = nks_; ntf = K / BK; ntk = ntf / nks_; G = G_; c = c_; which = which_; }
    __device__ bool next(int i, Unit& u) const {
        int L = i * G + c;
        if (which == 2) { if (L >= nN * nks) return false; const int ks = L / nN; u.pm = 64; u.pn = L % nN; u.k0 = ks * ntk; u.nt = ntk; u.split = nks > 1 ? ks : -1; return true; }
        const int nsp = nks > 1 ? nN * nks : 0;
        if (L < nsp) { const int ks = L / nN; u.pm = 64; u.pn = L % nN; u.k0 = ks * ntk; u.nt = ntk; u.split = ks; return true; }
        L -= nsp;
        if (L < nwgp) {
            const int q = nwgp / NXCD, xcd = L % NXCD, off = L / NXCD; const int wgid = xcd * q + off;
            const int nig = WGM * nN, gid = wgid / nig, fm = gid * WGM;
            u.pm = fm + ((wgid % nig) % WGM); u.pn = (wgid % nig) / WGM; u.k0 = 0; u.nt = ntf; u.split = -1; return true;
        }
        if (nks > 1 || which == 1) return false;
        const int j = L - nwgp; if (j >= nN) return false;
        u.pm = 64; u.pn = j; u.k0 = 0; u.nt = ntf; u.split = -1; return true;
    }
};
struct SplitCtx { float* part; unsigned* cnt; int nks; };
template <class Epi, class Sched, bool ALIGN_EPI, bool SP2>
__device__ __forceinline__ void gemm_phase(LAS unsigned char* lds, const Gemm g, const Sched& S, const Epi& E, const SplitCtx sc) {
    int tid_ = threadIdx.x; asm volatile("" : "+v"(tid_));
    const int tid = tid_, wid = __builtin_amdgcn_readfirstlane(tid >> 6), lane = tid & 63, wr = wid >> 2, wc = wid & 3, fr = lane & 15, fq = lane >> 4;
    const int K = g.K;
    unsigned voffA[2], voffB[2];
#pragma unroll
    for (int i = 0; i < 2; ++i) { int R, C; stage_rc(tid * 16 + i * 8192, R, C); const int Rb = Epi::PERM ? ((R & ~31) + perm32(R & 31)) : R;
        voffA[i] = (unsigned)(R * K + C) * 2u; voffB[i] = (unsigned)(Rb * K + C) * 2u; }
    const size_t kstep = (size_t)(BK * 2);
    const size_t hstep = (size_t)HALF * K * 2;
    const size_t tstep = 2 * hstep;
    const unsigned ldsw = (unsigned)wid * 1024u;
    const int aoff = lds_byte(wr * 64 + fr, fq * 8), boff = lds_byte(wc * 32 + fr, fq * 8);
#define PG8_SA(b, h) (((b) * 2 + (h)) * HTB)
#define PG8_SB(b, h) ((4 + (b) * 2 + (h)) * HTB)
#define PG8_STAGE(bufoff, gbase, voff) do { _Pragma("unroll") for (int _i = 0; _i < 2; ++_i) \
        __builtin_amdgcn_global_load_lds((const unsigned*)((const char*)(gbase) + (voff)[_i]), (LAS unsigned*)(lds + (bufoff) + ldsw + _i * 8192), 16, 0, 0); } while (0)
#define PG8_LDA(dst, b, h) do { _Pragma("unroll") for (int m = 0; m < 4; ++m) _Pragma("unroll") for (int k = 0; k < 2; ++k) dst[m][k] = *(const LAS bf16x8*)(lds + PG8_SA(b, h) + aoff + m * 2048 + k * 1024); } while (0)
#define PG8_LDB(dst, b, h) do { _Pragma("unroll") for (int n = 0; n < 2; ++n) _Pragma("unroll") for (int k = 0; k < 2; ++k) dst[n][k] = *(const LAS bf16x8*)(lds + PG8_SB(b, h) + boff + n * 2048 + k * 1024); } while (0)
#define PG8_MMA(ai, bj, At, Bt) do { __builtin_amdgcn_s_setprio(1); _Pragma("unroll") for (int m = 0; m < 4; ++m) _Pragma("unroll") for (int n = 0; n < 2; ++n) _Pragma("unroll") for (int k = 0; k < 2; ++k) \
        acc[ai][bj][m][n] = __builtin_amdgcn_mfma_f32_16x16x32_bf16(Bt[n][k], At[m][k], acc[ai][bj][m][n], 0, 0, 0); __builtin_amdgcn_s_setprio(0); } while (0)
#define PG8_WAIT_V(n) asm volatile("s_waitcnt vmcnt(" #n ")" ::: "memory")
#define PG8_WAIT_L(n) asm volatile("s_waitcnt lgkmcnt(" #n ")" ::: "memory")
#define PG8_BAR __builtin_amdgcn_s_barrier()
#define PG8_SCHED __builtin_amdgcn_sched_barrier(0)
    Unit cur, nxt; int ui = 0;
    if (!S.next(0, cur)) return;
    f32x4 acc[2][2][4][2];
#pragma unroll
    for (int a = 0; a < 2; ++a)
#pragma unroll
        for (int b = 0; b < 2; ++b)
#pragma unroll
            for (int m = 0; m < 4; ++m)
#pragma unroll
                for (int n = 0; n < 2; ++n) acc[a][b][m][n] = (f32x4){0.f, 0.f, 0.f, 0.f};
    bf16x8 At[4][2], B0[2][2], B1[2][2];
    const char* cA = (const char*)g.A + (size_t)cur.pm * tstep + (size_t)cur.k0 * kstep; const char* cB = (const char*)g.Bt + (size_t)cur.pn * tstep + (size_t)cur.k0 * kstep;
    if constexpr (SP2) {
        PG8_STAGE(PG8_SB(0, 0), cB, voffB); PG8_STAGE(PG8_SB(0, 1), cB + hstep, voffB); PG8_STAGE(PG8_SA(0, 0), cA, voffA); PG8_STAGE(PG8_SA(0, 1), cA + hstep, voffA);
        if (wr == 1) PG8_BAR;
        PG8_WAIT_V(2); PG8_BAR;
        PG8_STAGE(PG8_SB(1, 0), cB + kstep, voffB); PG8_STAGE(PG8_SA(1, 0), cA + kstep, voffA); PG8_STAGE(PG8_SB(1, 1), cB + hstep + kstep, voffB);
        PG8_WAIT_V(6); PG8_BAR;
    } else {
        PG8_STAGE(PG8_SB(0, 0), cB, voffB); PG8_STAGE(PG8_SA(0, 0), cA, voffA); PG8_STAGE(PG8_SB(0, 1), cB + hstep, voffB); PG8_STAGE(PG8_SA(0, 1), cA + hstep, voffA);
        if (wr == 1) PG8_BAR;
        PG8_WAIT_V(4); PG8_BAR;
        PG8_STAGE(PG8_SB(1, 0), cB + kstep, voffB); PG8_STAGE(PG8_SA(1, 0), cA + kstep, voffA); PG8_STAGE(PG8_SB(1, 1), cB + hstep + kstep, voffB);
        PG8_WAIT_V(6); PG8_BAR;
    }
    for (;;) {
        const bool has_next = S.next(ui + 1, nxt);
        const char* nA = has_next ? (const char*)g.A + (size_t)nxt.pm * tstep + (size_t)nxt.k0 * kstep : cA; const char* nB = has_next ? (const char*)g.Bt + (size_t)nxt.pn * tstep + (size_t)nxt.k0 * kstep : cB;
        const int nt = cur.nt;
        for (int t = 0; t < nt; t += 2) {
            const bool last = (t == nt - 2);
            const char* a1 = cA + (size_t)(t + 1) * kstep;
            const char* a2 = last ? nA : cA + (size_t)(t + 2) * kstep; const char* b2 = last ? nB : cB + (size_t)(t + 2) * kstep;
            const char* a3 = a2 + kstep; const char* b3 = b2 + kstep;
            if constexpr (SP2) {
            PG8_LDB(B0, 0, 0); PG8_LDB(B1, 0, 1); PG8_SCHED; PG8_LDA(At, 0, 0); PG8_STAGE(PG8_SA(1, 1), a1 + hstep, voffA);
            PG8_WAIT_V(8); PG8_WAIT_L(0); PG8_BAR; PG8_MMA(0, 0, At, B0); PG8_MMA(0, 1, At, B1); PG8_BAR; PG8_SCHED;
            PG8_LDA(At, 0, 1); PG8_STAGE(PG8_SB(0, 0), b2, voffB); PG8_STAGE(PG8_SB(0, 1), b2 + hstep, voffB); PG8_STAGE(PG8_SA(0, 0), a2, voffA);
            PG8_WAIT_V(8); PG8_WAIT_L(0); PG8_BAR; PG8_MMA(1, 0, At, B0); PG8_MMA(1, 1, At, B1); PG8_BAR; PG8_SCHED;
            PG8_LDB(B0, 1, 0); PG8_LDB(B1, 1, 1); PG8_SCHED; PG8_LDA(At, 1, 0); PG8_STAGE(PG8_SA(0, 1), a2 + hstep, voffA);
            PG8_WAIT_V(8); PG8_WAIT_L(0); PG8_BAR; PG8_MMA(0, 0, At, B0); PG8_MMA(0, 1, At, B1); PG8_BAR; PG8_SCHED;
            PG8_LDA(At, 1, 1); PG8_STAGE(PG8_SB(1, 0), b3, voffB); PG8_STAGE(PG8_SB(1, 1), b3 + hstep, voffB); PG8_STAGE(PG8_SA(1, 0), a3, voffA);
            PG8_WAIT_V(8); PG8_WAIT_L(0); PG8_BAR; PG8_MMA(1, 0, At, B0); PG8_MMA(1, 1, At, B1); PG8_BAR; PG8_SCHED;
            } else {
            PG8_LDB(B0, 0, 0); PG8_SCHED; PG8_LDA(At, 0, 0); PG8_STAGE(PG8_SA(1, 1), a1 + hstep, voffA);
            PG8_WAIT_L(8); PG8_BAR; PG8_WAIT_L(0); PG8_MMA(0, 0, At, B0); PG8_BAR; PG8_SCHED;
            PG8_LDB(B1, 0, 1); PG8_STAGE(PG8_SB(0, 0), b2, voffB);
            PG8_BAR; PG8_WAIT_L(0); PG8_MMA(0, 1, At, B1); PG8_BAR;
            PG8_LDA(At, 0, 1); PG8_STAGE(PG8_SA(0, 0), a2, voffA);
            PG8_BAR; PG8_WAIT_L(0); PG8_MMA(1, 0, At, B0); PG8_BAR; PG8_SCHED;
            PG8_STAGE(PG8_SB(0, 1), b2 + hstep, voffB);
            PG8_WAIT_V(6); PG8_BAR; PG8_MMA(1, 1, At, B1); PG8_BAR;
            PG8_LDB(B0, 1, 0); PG8_SCHED; PG8_LDA(At, 1, 0); PG8_STAGE(PG8_SA(0, 1), a2 + hstep, voffA);
            PG8_WAIT_L(8); PG8_BAR; PG8_WAIT_L(0); PG8_MMA(0, 0, At, B0); PG8_BAR; PG8_SCHED;
            PG8_LDB(B1, 1, 1); PG8_STAGE(PG8_SB(1, 0), b3, voffB);
            PG8_BAR; PG8_WAIT_L(0); PG8_MMA(0, 1, At, B1); PG8_BAR;
            PG8_LDA(At, 1, 1); PG8_STAGE(PG8_SA(1, 0), a3, voffA);
            PG8_BAR; PG8_WAIT_L(0); PG8_MMA(1, 0, At, B0); PG8_BAR; PG8_SCHED;
            PG8_STAGE(PG8_SB(1, 1), b3 + hstep, voffB);
            PG8_WAIT_V(6); PG8_BAR; PG8_MMA(1, 1, At, B1); PG8_BAR;
            }
        }
        if constexpr (ALIGN_EPI) { if (wr == 0) PG8_BAR; }
        if (cur.split < 0) E(acc, cur, wr, wc, fr, fq);
        else {
            float* slab = sc.part + (size_t)cur.split * (128 * g.N) + cur.pn * 256;
#pragma unroll
            for (int m = 0; m < 4; ++m)
#pragma unroll
                for (int bj = 0; bj < 2; ++bj)
#pragma unroll
                    for (int n = 0; n < 2; ++n) *(f32x4*)(slab + (size_t)(wr * 64 + m * 16 + fr) * g.N + bj * 128 + wc * 32 + (Epi::PERM ? 8 * fq + 4 * n : n * 16 + 4 * fq)) = acc[0][bj][m][n];
            asm volatile("s_waitcnt vmcnt(0) lgkmcnt(0)" ::: "memory"); __builtin_amdgcn_s_barrier(); asm volatile("" ::: "memory");
            if (tid == 0) {
                __builtin_amdgcn_fence(__ATOMIC_RELEASE, "agent");
                asm volatile("s_waitcnt vmcnt(0)" ::: "memory");
                __hip_atomic_fetch_add(sc.cnt, 1u, __ATOMIC_RELAXED, __HIP_MEMORY_SCOPE_AGENT);
            }
        }
        if (!has_next) break;
#pragma unroll
        for (int a = 0; a < 2; ++a)
#pragma unroll
            for (int b = 0; b < 2; ++b)
#pragma unroll
                for (int m = 0; m < 4; ++m)
#pragma unroll
                    for (int n = 0; n < 2; ++n) acc[a][b][m][n] = (f32x4){0.f, 0.f, 0.f, 0.f};
        cur = nxt; cA = nA; cB = nB; ++ui;
        if constexpr (ALIGN_EPI) { if (wr == 1) PG8_BAR; }
    }
    PG8_WAIT_V(0);
    if constexpr (!ALIGN_EPI) { if (wr == 0) PG8_BAR; }
    PG8_BAR;
#undef PG8_SA
#undef PG8_SB
#undef PG8_STAGE
#undef PG8_LDA
#undef PG8_LDB
#undef PG8_MMA
#undef PG8_WAIT_V
#undef PG8_WAIT_L
#undef PG8_BAR
#undef PG8_SCHED
}
}

struct EpiGateUp {
    static constexpr bool PERM = true;
    bf16_t* act; const float* ss;
    __device__ __forceinline__ void operator()(const f32x4 (&acc)[2][2][4][2], const pg8::Unit& u, int wr, int wc, int fr, int fq) const {
        float ssv[2][4];
#pragma unroll
        for (int ai = 0; ai < 2; ++ai)
#pragma unroll
            for (int m = 0; m < 4; ++m) ssv[ai][m] = ss[u.pm * 256 + ai * 128 + wr * 64 + m * 16 + fr];
#pragma unroll
        for (int ai = 0; ai < 2; ++ai)
#pragma unroll
            for (int m = 0; m < 4; ++m) {
                const int row = u.pm * 256 + ai * 128 + wr * 64 + m * 16 + fr;
                const float rs = __builtin_amdgcn_rsqf(ssv[ai][m] * (1.0f / DM) + EPS);
                float v[8];
#pragma unroll
                for (int n = 0; n < 2; ++n)
#pragma unroll
                    for (int i = 0; i < 4; ++i) { const float gt = acc[ai][0][m][n][i] * rs, up = acc[ai][1][m][n][i] * rs; v[n * 4 + i] = gt * sigmoidf_(gt) * up; }
                u32x4 w; w.x = pk2(v[0], v[1]); w.y = pk2(v[2], v[3]); w.z = pk2(v[4], v[5]); w.w = pk2(v[6], v[7]);
                *(u32x4*)(act + (size_t)row * DFF + u.pn * 128 + wc * 32 + 8 * fq) = w;
            }
    }
};
template <bool BASE_X> struct EpiResid {
    static constexpr bool PERM = true;
    const float* xp; const float* xs; bf16_t* hb; float* ssn; float scale;
    __device__ __forceinline__ void operator()(const f32x4 (&acc)[2][2][4][2], const pg8::Unit& u, int wr, int wc, int fr, int fq) const {
#pragma unroll
        for (int ai = 0; ai < 2; ++ai) {
            u32x2 hw[4][2][2];
#pragma unroll
            for (int m = 0; m < 4; ++m) {
                const int row = u.pm * 256 + ai * 128 + wr * 64 + m * 16 + fr;
#pragma unroll
                for (int bj = 0; bj < 2; ++bj)
#pragma unroll
                    for (int n = 0; n < 2; ++n) hw[m][bj][n] = *(const u32x2*)(hb + (size_t)row * DM + u.pn * 256 + bj * 128 + wc * 32 + 8 * fq + 4 * n);
            }
#pragma unroll
            for (int m = 0; m < 4; ++m) {
                const int row = u.pm * 256 + ai * 128 + wr * 64 + m * 16 + fr;
                float sq = 0.f;
#pragma unroll
                for (int bj = 0; bj < 2; ++bj)
#pragma unroll
                    for (int n = 0; n < 2; ++n) {
                        const int col = u.pn * 256 + bj * 128 + wc * 32 + 8 * fq + 4 * n;
                        const u32x2 h2 = hw[m][bj][n];
                        const f32x4 hv = (f32x4){bflo(h2.x), bfhi(h2.x), bflo(h2.y), bfhi(h2.y)} + acc[ai][bj][m][n] * scale;
                        u32x2 w; w.x = pk2(hv[0], hv[1]); w.y = pk2(hv[2], hv[3]);
                        *(u32x2*)(hb + (size_t)row * DM + col) = w;
                        sq += (hv[0] * hv[0] + hv[1] * hv[1]) + (hv[2] * hv[2] + hv[3] * hv[3]);
                    }
                sq += __shfl_xor(sq, 16); sq += __shfl_xor(sq, 32);
                if (fq == 0) atomicAdd(ssn + row, sq);
            }
        }
    }
};
struct EpiFinal {
    static constexpr bool PERM = true;
    float* out; const bf16_t* hb; float* ssn; unsigned* pcnt; const float* gamma; float scale;
    __device__ __forceinline__ void operator()(f32x4 (&acc)[2][2][4][2], const pg8::Unit& u, int wr, int wc, int fr, int fq) const {
#pragma unroll
        for (int ai = 0; ai < 2; ++ai) {
            u32x2 hwv[4][2][2];
#pragma unroll
            for (int m = 0; m < 4; ++m) {
                const int row = u.pm * 256 + ai * 128 + wr * 64 + m * 16 + fr;
#pragma unroll
                for (int bj = 0; bj < 2; ++bj)
#pragma unroll
                    for (int n = 0; n < 2; ++n) hwv[m][bj][n] = *(const u32x2*)(hb + (size_t)row * DM + u.pn * 256 + bj * 128 + wc * 32 + 8 * fq + 4 * n);
            }
#pragma unroll
            for (int m = 0; m < 4; ++m) {
                const int row = u.pm * 256 + ai * 128 + wr * 64 + m * 16 + fr;
                float sq = 0.f;
#pragma unroll
                for (int bj = 0; bj < 2; ++bj)
#pragma unroll
                    for (int n = 0; n < 2; ++n) {
                        const u32x2 hw = hwv[m][bj][n];
                        const f32x4 hv = (f32x4){bflo(hw.x), bfhi(hw.x), bflo(hw.y), bfhi(hw.y)} + acc[ai][bj][m][n] * scale;
                        acc[ai][bj][m][n] = hv;
                        sq += (hv[0] * hv[0] + hv[1] * hv[1]) + (hv[2] * hv[2] + hv[3] * hv[3]);
                    }
                sq += __shfl_xor(sq, 16); sq += __shfl_xor(sq, 32);
                if (fq == 0) atomicAdd(ssn + row, sq);
            }
        }
        asm volatile("s_waitcnt vmcnt(0) lgkmcnt(0)" ::: "memory"); __builtin_amdgcn_s_barrier(); asm volatile("" ::: "memory");
        if (wr == 0 && wc == 0 && fr == 0 && fq == 0) {
            __hip_atomic_fetch_add(pcnt + u.pm, 1u, __ATOMIC_RELAXED, __HIP_MEMORY_SCOPE_AGENT);
            unsigned sp = 0;
            while (__hip_atomic_load(pcnt + u.pm, __ATOMIC_RELAXED, __HIP_MEMORY_SCOPE_AGENT) < 4u) { __builtin_amdgcn_s_sleep(1); if (++sp > (1u << 22)) break; }
        }
        asm volatile("s_waitcnt vmcnt(0) lgkmcnt(0)" ::: "memory"); __builtin_amdgcn_s_barrier(); asm volatile("" ::: "memory");
        float sv[2][4]; f32x4 gnv[2][2];
#pragma unroll
        for (int ai = 0; ai < 2; ++ai)
#pragma unroll
            for (int m = 0; m < 4; ++m) sv[ai][m] = __hip_atomic_load(ssn + u.pm * 256 + ai * 128 + wr * 64 + m * 16 + fr, __ATOMIC_RELAXED, __HIP_MEMORY_SCOPE_AGENT);
#pragma unroll
        for (int bj = 0; bj < 2; ++bj)
#pragma unroll
            for (int n = 0; n < 2; ++n) gnv[bj][n] = *(const f32x4*)(gamma + u.pn * 256 + bj * 128 + wc * 32 + 8 * fq + 4 * n);
#pragma unroll
        for (int ai = 0; ai < 2; ++ai)
#pragma unroll
            for (int m = 0; m < 4; ++m) {
                const int row = u.pm * 256 + ai * 128 + wr * 64 + m * 16 + fr;
                const float rs = __builtin_amdgcn_rsqf(sv[ai][m] * (1.0f / DM) + EPS);
#pragma unroll
                for (int bj = 0; bj < 2; ++bj)
#pragma unroll
                    for (int n = 0; n < 2; ++n) {
                        const int col = u.pn * 256 + bj * 128 + wc * 32 + 8 * fq + 4 * n;
                        *(f32x4*)(out + (size_t)row * DM + col) = acc[ai][bj][m][n] * rs * gnv[bj][n];
                    }
            }
    }
};
struct EpiInProj {
    static constexpr bool PERM = true;
    bf16_t* p; const float* ss;
    __device__ __forceinline__ void operator()(const f32x4 (&acc)[2][2][4][2], const pg8::Unit& u, int wr, int wc, int fr_, int fq_) const {
        int fr = fr_, fq = fq_; asm volatile("" : "+v"(fr), "+v"(fq));
#pragma unroll
        for (int ai = 0; ai < 2; ++ai)
#pragma unroll
            for (int m = 0; m < 4; ++m) {
                const int row = u.pm * 256 + ai * 128 + wr * 64 + m * 16 + fr;
                const float rs = __builtin_amdgcn_rsqf(ss[row] * (1.0f / DM) + EPS);
                if (u.pn < 4) {
#pragma unroll
                    for (int bj = 0; bj < 2; ++bj) {
                        const f32x4 a = acc[ai][bj][m][0] * rs, b = acc[ai][bj][m][1] * rs;
                        u32x4 w; w.x = pk2(a[0], a[1]); w.y = pk2(a[2], a[3]); w.z = pk2(b[0], b[1]); w.w = pk2(b[2], b[3]);
                        *(u32x4*)(p + (size_t)row * PW + u.pn * 256 + bj * 128 + wc * 32 + 8 * fq) = w;
                    }
                } else {
                    const float r2 = rs * rs;
                    const f32x4 a = acc[ai][0][m][0] * acc[ai][1][m][0] * r2, b = acc[ai][0][m][1] * acc[ai][1][m][1] * r2;
                    u32x4 w; w.x = pk2(a[0], a[1]); w.y = pk2(a[2], a[3]); w.z = pk2(b[0], b[1]); w.w = pk2(b[2], b[3]);
                    *(u32x4*)(p + (size_t)row * PW + 1024 + (u.pn - 4) * 128 + wc * 32 + 8 * fq) = w;
                }
            }
    }
};
struct EpiPartOnly {
    static constexpr bool PERM = true;
    __device__ __forceinline__ void operator()(const f32x4 (&)[2][2][4][2], const pg8::Unit&, int, int, int, int) const {}
};
struct EpiGlu {
    static constexpr bool PERM = true;
    const bf16_t* z; const float* bias; bf16_t* mix;
    __device__ __forceinline__ void operator()(const f32x4 (&acc)[2][2][4][2], const pg8::Unit& u, int wr, int wc, int fr, int fq) const {
#pragma unroll
        for (int bj = 0; bj < 2; ++bj) {
            const int col = u.pn * 256 + bj * 128 + wc * 32 + 8 * fq;
            const f32x4 b0 = *(const f32x4*)(bias + col), b1 = *(const f32x4*)(bias + col + 4);
            u32x4 zv[2][4];
#pragma unroll
            for (int ai = 0; ai < 2; ++ai)
#pragma unroll
                for (int m = 0; m < 4; ++m) zv[ai][m] = *(const u32x4*)(z + (size_t)(u.pm * 256 + ai * 128 + wr * 64 + m * 16 + fr) * SSMW + col);
#pragma unroll
            for (int ai = 0; ai < 2; ++ai)
#pragma unroll
                for (int m = 0; m < 4; ++m) {
                    const int row = u.pm * 256 + ai * 128 + wr * 64 + m * 16 + fr;
                    const u32x4 zz = zv[ai][m];
                    const f32x4 a = acc[ai][bj][m][0] + b0, b = acc[ai][bj][m][1] + b1;
                    u32x4 w;
                    w.x = pk2(bflo(zz.x) * sigmoidf_(a[0]), bfhi(zz.x) * sigmoidf_(a[1]));
                    w.y = pk2(bflo(zz.y) * sigmoidf_(a[2]), bfhi(zz.y) * sigmoidf_(a[3]));
                    w.z = pk2(bflo(zz.z) * sigmoidf_(b[0]), bfhi(zz.z) * sigmoidf_(b[1]));
                    w.w = pk2(bflo(zz.w) * sigmoidf_(b[2]), bfhi(zz.w) * sigmoidf_(b[3]));
                    *(u32x4*)(mix + (size_t)row * DM + col) = w;
                }
        }
    }
};

template <bool BASE_X, bool WRITE_HB, int NKS>
__device__ __forceinline__ void sample_finalize(const float* part, unsigned* cnt, int nks, int nsplit_units, const float* xs, float* out, bf16_t* hb, float* ssn, float scale,
                                                int bid, int wave, int lane, int tid, LAS unsigned char* lds) {
    if (bid >= 128) return;
    if (tid == 0) {
        unsigned sp = 0;
        while (__hip_atomic_load(cnt, __ATOMIC_RELAXED, __HIP_MEMORY_SCOPE_AGENT) < (unsigned)nsplit_units) { __builtin_amdgcn_s_sleep(2); if (++sp > (1u << 22)) break; }
        __builtin_amdgcn_fence(__ATOMIC_ACQUIRE, "agent");
        asm volatile("s_waitcnt vmcnt(0)" ::: "memory");
    }
    __syncthreads();
    if (wave < 4) {
        const int r = bid, col = wave * 256 + lane * 4, row = NPROMPT + r;
        f32x4 pv[NKS];
#pragma unroll
        for (int ks = 0; ks < NKS; ++ks) pv[ks] = *(const f32x4*)(part + ((size_t)ks * 128 + r) * DM + col);
        f32x4 s = (f32x4){0.f, 0.f, 0.f, 0.f};
#pragma unroll
        for (int ks = 0; ks < NKS; ++ks) s += pv[ks];
        f32x4 hv; { const u32x2 hw = *(const u32x2*)(hb + (size_t)row * DM + col); hv = (f32x4){bflo(hw.x), bfhi(hw.x), bflo(hw.y), bfhi(hw.y)} + s * scale; }
        if (WRITE_HB) { u32x2 w; w.x = pk2(hv[0], hv[1]); w.y = pk2(hv[2], hv[3]); *(u32x2*)(hb + (size_t)row * DM + col) = w; }
        float sq = (hv[0] * hv[0] + hv[1] * hv[1]) + (hv[2] * hv[2] + hv[3] * hv[3]);
        sq = wave_sum(sq);
        if (lane == 0) atomicAdd(ssn + row, sq);
    }
}

template <int NKS>
__device__ __forceinline__ void sample_finalize_norm(const float* part, unsigned* cnt, int nks, int nsplit_units, float* out, const bf16_t* hb, const float* gamma, float scale,
                                                     int bid, int wave, int lane, int tid, LAS unsigned char* lds) {
    if (bid >= 128) return;
    if (tid == 0) {
        unsigned sp = 0;
        while (__hip_atomic_load(cnt, __ATOMIC_RELAXED, __HIP_MEMORY_SCOPE_AGENT) < (unsigned)nsplit_units) { __builtin_amdgcn_s_sleep(2); if (++sp > (1u << 22)) break; }
        __builtin_amdgcn_fence(__ATOMIC_ACQUIRE, "agent");
        asm volatile("s_waitcnt vmcnt(0)" ::: "memory");
    }
    __syncthreads();
    LAS float* red = (LAS float*)(lds + 131072 + 1024);
    const int r = bid, col = (wave & 3) * 256 + lane * 4, row = NPROMPT + r;
    f32x4 hv = (f32x4){0.f, 0.f, 0.f, 0.f};
    if (wave < 4) {
        f32x4 pv[NKS];
#pragma unroll
        for (int ks = 0; ks < NKS; ++ks) pv[ks] = *(const f32x4*)(part + ((size_t)ks * 128 + r) * DM + col);
        f32x4 s = (f32x4){0.f, 0.f, 0.f, 0.f};
#pragma unroll
        for (int ks = 0; ks < NKS; ++ks) s += pv[ks];
        { const u32x2 hw = *(const u32x2*)(hb + (size_t)row * DM + col); hv = (f32x4){bflo(hw.x), bfhi(hw.x), bflo(hw.y), bfhi(hw.y)} + s * scale; }
        float sq = (hv[0] * hv[0] + hv[1] * hv[1]) + (hv[2] * hv[2] + hv[3] * hv[3]);
        sq = wave_sum(sq);
        if (lane == 0) red[wave] = sq;
    }
    __syncthreads();
    if (wave < 4) {
        const float tot = (red[0] + red[1]) + (red[2] + red[3]);
        const float rs = __builtin_amdgcn_rsqf(tot * (1.0f / DM) + EPS);
        const f32x4 gn = *(const f32x4*)(gamma + col);
        *(f32x4*)(out + (size_t)row * DM + col) = hv * rs * gn;
    }
}

template <int NKS>
__device__ __forceinline__ void sample_finalize_inproj(const float* part, unsigned* cnt, int nsplit_units, const float* ss, bf16_t* p, int bid, int wave, int lane, int tid) {
    if (tid == 0) {
        unsigned sp = 0;
        while (__hip_atomic_load(cnt, __ATOMIC_RELAXED, __HIP_MEMORY_SCOPE_AGENT) < (unsigned)nsplit_units) { __builtin_amdgcn_s_sleep(2); if (++sp > (1u << 22)) break; }
        __builtin_amdgcn_fence(__ATOMIC_ACQUIRE, "agent");
        asm volatile("s_waitcnt vmcnt(0)" ::: "memory");
    }
    __syncthreads();
    const int r = bid * 4 + (wave >> 1), row = NPROMPT + r;
    const float rs = __builtin_amdgcn_rsqf(ss[row] * (1.0f / DM) + EPS);
    if ((wave & 1) == 0) {
        const int col = lane * 16;
        f32x4 pv[NKS][4];
#pragma unroll
        for (int ks = 0; ks < NKS; ++ks)
#pragma unroll
            for (int j = 0; j < 4; ++j) pv[ks][j] = *(const f32x4*)(part + ((size_t)ks * 128 + r) * PW + col + 4 * j);
        u32x4 w[2];
#pragma unroll
        for (int j = 0; j < 4; ++j) {
            f32x4 s = pv[0][j];
#pragma unroll
            for (int ks = 1; ks < NKS; ++ks) s += pv[ks][j];
            s = s * rs;
            w[j >> 1][(j & 1) * 2] = pk2(s[0], s[1]); w[j >> 1][(j & 1) * 2 + 1] = pk2(s[2], s[3]);
        }
        *(u32x4*)(p + (size_t)row * PW + col) = w[0];
        *(u32x4*)(p + (size_t)row * PW + col + 8) = w[1];
    } else {
        const int chn = lane * 8, xcol = 1024 + (chn >> 7) * 256 + (chn & 127);
        f32x4 px[NKS][2], pg[NKS][2];
#pragma unroll
        for (int ks = 0; ks < NKS; ++ks)
#pragma unroll
            for (int j = 0; j < 2; ++j) { px[ks][j] = *(const f32x4*)(part + ((size_t)ks * 128 + r) * PW + xcol + 4 * j); pg[ks][j] = *(const f32x4*)(part + ((size_t)ks * 128 + r) * PW + xcol + 128 + 4 * j); }
        const float r2 = rs * rs;
        u32x4 w;
#pragma unroll
        for (int j = 0; j < 2; ++j) {
            f32x4 sx = px[0][j], sg = pg[0][j];
#pragma unroll
            for (int ks = 1; ks < NKS; ++ks) { sx += px[ks][j]; sg += pg[ks][j]; }
            const f32x4 v = sx * sg * r2;
            w[2 * j] = pk2(v[0], v[1]); w[2 * j + 1] = pk2(v[2], v[3]);
        }
        *(u32x4*)(p + (size_t)row * PW + 1024 + chn) = w;
    }
}

__device__ __forceinline__ void transpose_item(const float* W, int N, int k0, int n0, bf16_t* WT, int K, int drow0, const float* gain, LAS float* scr, int lane) {
    float wv[32];
    const float* wp = W + (size_t)(k0 + (lane >> 5)) * N + n0 + (lane & 31);
#pragma unroll
    for (int i = 0; i < 32; ++i) wv[i] = wp[(size_t)(2 * i) * N];
    const float gsc = gain ? gain[k0 + lane] : 1.0f;
#pragma unroll
    for (int i = 0; i < 32; ++i) { const int kk = 2 * i + (lane >> 5); scr[kk * 33 + (lane & 31)] = wv[i] * __shfl(gsc, kk); }
    LDS_WAIT();
    const int c = lane & 7;
#pragma unroll
    for (int j = 0; j < 4; ++j) { const int n = (lane >> 3) + 8 * j; const LAS float* s = scr + (8 * c) * 33 + n;
        u32x4 o; o.x = pk2(s[0 * 33], s[1 * 33]); o.y = pk2(s[2 * 33], s[3 * 33]); o.z = pk2(s[4 * 33], s[5 * 33]); o.w = pk2(s[6 * 33], s[7 * 33]);
        *(u32x4*)(WT + (size_t)(drow0 + n) * K + k0 + 8 * c) = o; }
    LDS_WAIT();
}
template <int GU>
__device__ __forceinline__ void transpose_matrix(const float* W, int K, int N, bf16_t* WT, const float* gain, LAS float* scr, int lane, int gw, int NGW) {
    const int nblk = N / 32, nitems = (K / 64) * nblk;
    for (int it = gw; it < nitems; it += NGW) {
        const int kb = it / nblk, nb = it % nblk, n0 = nb * 32;
        int drow0;
        if (GU == 0) drow0 = n0;
        else if (GU == 3) {
            const int seg = n0 >> 9, j = n0 & 511;
            drow0 = seg == 0 ? j : seg == 2 ? 512 + j : (4 + (j >> 7)) * 256 + (j & 127) + (seg == 3 ? 128 : 0);
        } else drow0 = 256 * (n0 / 128) + (n0 % 128) + (GU == 2 ? 128 : 0);
        transpose_item(W, N, kb * 64, n0, WT, K, drow0, gain, scr, lane);
    }
}

__device__ __forceinline__ int tau32(int r) { return (r & 3) + 4 * (r >> 3) + 16 * ((r >> 2) & 1); }
constexpr int XS_STRIDE = 272, XS_BYTES = 32 * XS_STRIDE;

template <int MODE>
__device__ __forceinline__ void ssm_item(const Params& P, LAS unsigned char* xs, int lane, int item) {
    unsigned char* ws = P.ws;
    const bf16_t* pb = (const bf16_t*)(ws + WS_P);
    bf16_t* zb = (bf16_t*)(ws + WS_Z);
    const float2* tab_ab = (const float2*)(ws + WS_TAB + T_AB);
    const float2* tab_ab16 = (const float2*)(ws + WS_TAB + T_AB16);
    const float2* tab_ab128 = (const float2*)(ws + WS_TAB + T_AB128);
    float2* Eb = (float2*)(ws + WS_E);
    const int c = lane & 31, h = lane >> 5;
    int g, b = 0, ch = 0, row0, nblk;
    if (MODE == 2) { g = item & 31; const int sb = item >> 5; row0 = NPROMPT + sb * 32; nblk = 1; b = sb * 32; }
    else { g = item & 31; ch = (item >> 5) % NCH; b = item / (32 * NCH); row0 = b * SEQ + ch * TCH; nblk = TCH / 32; }
    const float2 a0 = tab_ab[g * 64 + c], a1 = tab_ab[g * 64 + c + 32];
    bf16x8 bfr[4];
#pragma unroll
    for (int nt = 0; nt < 4; ++nt) bfr[nt] = *(const bf16x8*)(ws + WS_TAB + T_BF + ((size_t)(g * 4 + nt) * 64 + lane) * 16);
    bf16x8 cfr[4];
    f32x4 dsk4 = (f32x4){0.f, 0.f, 0.f, 0.f};
    if (MODE != 0) {
#pragma unroll
        for (int kk = 0; kk < 4; ++kk) cfr[kk] = *(const bf16x8*)(ws + WS_TAB + T_CF + ((size_t)(g * 4 + kk) * 64 + lane) * 16);
        dsk4 = *(const f32x4*)(P.in[18] + g * 16 + 4 * (lane >> 4));
    }
    float X0r = 0.f, X0i = 0.f, X1r = 0.f, X1i = 0.f;
    if (MODE == 1) {
        const float2 p0 = tab_ab128[g * 64 + c], p1 = tab_ab128[g * 64 + c + 32];
        const float2* e0p = Eb + ((size_t)(b * NCH) * 32 + g) * 64 + c;
        for (int cc0 = 0; cc0 < ch; cc0 += 4) {
            float2 e0[4], e1[4];
#pragma unroll
            for (int q = 0; q < 4; ++q) { const int cc = (cc0 + q < ch) ? cc0 + q : ch - 1; e0[q] = e0p[(size_t)cc * 2048]; e1[q] = e0p[(size_t)cc * 2048 + 32]; }
#pragma unroll
            for (int q = 0; q < 4; ++q) if (cc0 + q < ch) {
                const float t0r = p0.x * X0r - p0.y * X0i + e0[q].x, t0i = p0.x * X0i + p0.y * X0r + e0[q].y; X0r = t0r; X0i = t0i;
                const float t1r = p1.x * X1r - p1.y * X1i + e1[q].x, t1i = p1.x * X1i + p1.y * X1r + e1[q].y; X1r = t1r; X1i = t1i;
            }
        }
    }
    const int tok = tau32(c);
    constexpr int NBLK = (MODE == 2) ? 1 : TCH / 32;
    bf16x8 afr[NBLK];
#pragma unroll
    for (int blk = 0; blk < NBLK; ++blk) afr[blk] = *(const bf16x8*)(pb + (size_t)(row0 + blk * 32 + tok) * PW + g * 16 + 8 * h);
#pragma unroll
    for (int blk = 0; blk < NBLK; ++blk) {
        const int rb = row0 + blk * 32;
        const bf16x8 af = afr[blk];
        u32x2 uraw[2];
        if (MODE != 0) {
#pragma unroll
            for (int tb = 0; tb < 2; ++tb) uraw[tb] = *(const u32x2*)(pb + (size_t)(rb + tb * 16 + (lane & 15)) * PW + g * 16 + 4 * (lane >> 4));
        }
        f32x16 D0, D1, D2, D3;
        {
            f32x16 zz;
#pragma unroll
            for (int i = 0; i < 16; ++i) zz[i] = 0.f;
            D0 = __builtin_amdgcn_mfma_f32_32x32x16_bf16(af, bfr[0], zz, 0, 0, 0);
            D1 = __builtin_amdgcn_mfma_f32_32x32x16_bf16(af, bfr[1], zz, 0, 0, 0);
            D2 = __builtin_amdgcn_mfma_f32_32x32x16_bf16(af, bfr[2], zz, 0, 0, 0);
            D3 = __builtin_amdgcn_mfma_f32_32x32x16_bf16(af, bfr[3], zz, 0, 0, 0);
        }
        if (MODE == 2) {
            const float* sre = P.in[2]; const float* sim = P.in[3];
            float* ore = P.out + O_RES; float* oim = P.out + O_IMS;
            float h0r[16], h0i[16], h1r[16], h1i[16];
#pragma unroll
            for (int s = 0; s < 16; ++s) {
                const size_t o = ((size_t)(b + s + 16 * h) * 32 + g) * 64 + c;
                h0r[s] = sre[o]; h0i[s] = sim[o]; h1r[s] = sre[o + 32]; h1i[s] = sim[o + 32];
            }
#pragma unroll
            for (int s = 0; s < 16; ++s) {
                const size_t o = ((size_t)(b + s + 16 * h) * 32 + g) * 64 + c;
                D0[s] += a0.x * h0r[s] - a0.y * h0i[s]; D2[s] += a0.x * h0i[s] + a0.y * h0r[s];
                D1[s] += a1.x * h1r[s] - a1.y * h1i[s]; D3[s] += a1.x * h1i[s] + a1.y * h1r[s];
                ore[o] = D0[s]; oim[o] = D2[s]; ore[o + 32] = D1[s]; oim[o + 32] = D3[s];
            }
        } else {
            float x0r = h ? 0.f : X0r, x0i = h ? 0.f : X0i, x1r = h ? 0.f : X1r, x1i = h ? 0.f : X1i;
#pragma unroll
            for (int s = 0; s < 16; ++s) {
                const float n0r = a0.x * x0r - a0.y * x0i + D0[s], n0i = a0.x * x0i + a0.y * x0r + D2[s];
                const float n1r = a1.x * x1r - a1.y * x1i + D1[s], n1i = a1.x * x1i + a1.y * x1r + D3[s];
                x0r = n0r; x0i = n0i; x1r = n1r; x1i = n1i;
                D0[s] = x0r; D2[s] = x0i; D1[s] = x1r; D3[s] = x1i;
            }
            const float y0r = __shfl(x0r, c), y0i = __shfl(x0i, c), y1r = __shfl(x1r, c), y1i = __shfl(x1i, c);
            if (MODE == 0) {
                const float2 q0 = tab_ab16[g * 64 + c], q1 = tab_ab16[g * 64 + c + 32];
                const float e0r = x0r + q0.x * y0r - q0.y * y0i, e0i = x0i + q0.x * y0i + q0.y * y0r;
                const float e1r = x1r + q1.x * y1r - q1.y * y1i, e1i = x1i + q1.x * y1i + q1.y * y1r;
                X0r = __shfl(e0r, c + 32); X0i = __shfl(e0i, c + 32); X1r = __shfl(e1r, c + 32); X1i = __shfl(e1i, c + 32);
            } else {
                float c0r = h ? y0r : 0.f, c0i = h ? y0i : 0.f, c1r = h ? y1r : 0.f, c1i = h ? y1i : 0.f;
#pragma unroll
                for (int s = 0; s < 16; ++s) {
                    const float n0r = a0.x * c0r - a0.y * c0i, n0i = a0.x * c0i + a0.y * c0r;
                    const float n1r = a1.x * c1r - a1.y * c1i, n1i = a1.x * c1i + a1.y * c1r;
                    c0r = n0r; c0i = n0i; c1r = n1r; c1i = n1i;
                    D0[s] += c0r; D2[s] += c0i; D1[s] += c1r; D3[s] += c1i;
                }
                X0r = __shfl(D0[15], c + 32); X0i = __shfl(D2[15], c + 32); X1r = __shfl(D1[15], c + 32); X1i = __shfl(D3[15], c + 32);
            }
        }
        if (MODE != 0) {
#pragma unroll
            for (int s = 0; s < 16; ++s) {
                u32x2 w; w.x = cvt_pk_bf16(D0[s], D2[s]); w.y = cvt_pk_bf16(D1[s], D3[s]);
                *(LAS u32x2*)(xs + (s + 16 * h) * XS_STRIDE + c * 8) = w;
            }
            LDS_WAIT();
            const int chn = lane & 15, q = lane >> 4;
#pragma unroll
            for (int tb = 0; tb < 2; ++tb) {
                f32x4 y = (f32x4){0.f, 0.f, 0.f, 0.f};
#pragma unroll
                for (int kk = 0; kk < 4; ++kk) {
                    const bf16x8 xa = *(const LAS bf16x8*)(xs + (tb * 16 + chn) * XS_STRIDE + kk * 64 + q * 16);
                    y = __builtin_amdgcn_mfma_f32_16x16x32_bf16(cfr[kk], xa, y, 0, 0, 0);
                }
                {
                    const int row = rb + tb * 16 + chn;
                    const u32x2 uu = uraw[tb];
                    const float z0 = gelu_tanh(y[0] + dsk4[0] * bflo(uu.x)), z1 = gelu_tanh(y[1] + dsk4[1] * bfhi(uu.x));
                    const float z2 = gelu_tanh(y[2] + dsk4[2] * bflo(uu.y)), z3 = gelu_tanh(y[3] + dsk4[3] * bfhi(uu.y));
                    u32x2 w; w.x = cvt_pk_bf16(z0, z1); w.y = cvt_pk_bf16(z2, z3);
                    *(u32x2*)(zb + (size_t)row * SSMW + g * 16 + 4 * q) = w;
                }
            }
            LDS_WAIT();
        }
    }
    if (MODE == 0) {
        if (h == 0) { Eb[((size_t)(b * NCH + ch) * 32 + g) * 64 + c] = make_float2(X0r, X0i); Eb[((size_t)(b * NCH + ch) * 32 + g) * 64 + c + 32] = make_float2(X1r, X1i); }
    }
    if (MODE == 1) {
        if (ch == NCH - 1 && h == 0) {
            float* ore = P.out + O_REP; float* oim = P.out + O_IMP; const size_t o = ((size_t)b * 32 + g) * 64 + c;
            ore[o] = X0r; oim[o] = X0i; ore[o + 32] = X1r; oim[o + 32] = X1i;
        }
    }
}

template <int MODE>
__device__ __forceinline__ void ssm_pair_item(const Params& P, LAS unsigned char* xs, int lane, int item) {
    unsigned char* ws = P.ws;
    const bf16_t* pb = (const bf16_t*)(ws + WS_P);
    bf16_t* zb = (bf16_t*)(ws + WS_Z);
    const float2* tab_ab = (const float2*)(ws + WS_TAB + T_AB);
    const float2* tab_ab128 = (const float2*)(ws + WS_TAB + T_AB128);
    float2* Eb = (float2*)(ws + WS_E);
    const int c = lane & 31, h = lane >> 5;
    const int g = item & 31, ch = (item >> 5) % NCH, bp = item / (32 * NCH);
    const int bh = 2 * bp + h;
    const float2 a0 = tab_ab[g * 64 + c], a1 = tab_ab[g * 64 + c + 32];
    bf16x8 bfr[4];
#pragma unroll
    for (int nt = 0; nt < 4; ++nt) bfr[nt] = *(const bf16x8*)(ws + WS_TAB + T_BF + ((size_t)(g * 4 + nt) * 64 + lane) * 16);
    bf16x8 cfr[4];
    f32x4 dsk4 = (f32x4){0.f, 0.f, 0.f, 0.f};
    if (MODE != 0) {
#pragma unroll
        for (int kk = 0; kk < 4; ++kk) cfr[kk] = *(const bf16x8*)(ws + WS_TAB + T_CF + ((size_t)(g * 4 + kk) * 64 + lane) * 16);
        dsk4 = *(const f32x4*)(P.in[18] + g * 16 + 4 * (lane >> 4));
    }
    float x0r = 0.f, x0i = 0.f, x1r = 0.f, x1i = 0.f;
    if (MODE == 1) {
        const float2 p0 = tab_ab128[g * 64 + c], p1 = tab_ab128[g * 64 + c + 32];
        const float2* e0p = Eb + ((size_t)(bh * NCH) * 32 + g) * 64 + c;
        for (int cc0 = 0; cc0 < ch; cc0 += 4) {
            float2 e0[4], e1[4];
#pragma unroll
            for (int q = 0; q < 4; ++q) { const int cc = (cc0 + q < ch) ? cc0 + q : ch - 1; e0[q] = e0p[(size_t)cc * 2048]; e1[q] = e0p[(size_t)cc * 2048 + 32]; }
#pragma unroll
            for (int q = 0; q < 4; ++q) if (cc0 + q < ch) {
                const float t0r = p0.x * x0r - p0.y * x0i + e0[q].x, t0i = p0.x * x0i + p0.y * x0r + e0[q].y; x0r = t0r; x0i = t0i;
                const float t1r = p1.x * x1r - p1.y * x1i + e1[q].x, t1i = p1.x * x1i + p1.y * x1r + e1[q].y; x1r = t1r; x1i = t1i;
            }
        }
    }
    const int tok = tau32(c);
    const int arow0 = (2 * bp + (tok >> 4)) * SEQ + ch * TCH + (tok & 15);
    constexpr int NSB = TCH / 16;
#pragma unroll 1
    for (int sq4 = 0; sq4 < NSB / 4; ++sq4) {
    bf16x8 afr[4];
#pragma unroll
    for (int s4 = 0; s4 < 4; ++s4) afr[s4] = *(const bf16x8*)(pb + (size_t)(arow0 + (sq4 * 4 + s4) * 16) * PW + g * 16 + 8 * h);
#pragma unroll
    for (int s4 = 0; s4 < 4; ++s4) {
        const int sb = sq4 * 4 + s4;
        const int rb0 = (2 * bp) * SEQ + ch * TCH + sb * 16;
        const bf16x8 af = afr[s4];
        u32x2 uraw[2];
        if (MODE != 0) {
#pragma unroll
            for (int tb = 0; tb < 2; ++tb) uraw[tb] = *(const u32x2*)(pb + (size_t)(rb0 + tb * SEQ + (lane & 15)) * PW + g * 16 + 4 * (lane >> 4));
        }
        f32x16 D0, D1, D2, D3;
        {
            f32x16 zz;
#pragma unroll
            for (int i = 0; i < 16; ++i) zz[i] = 0.f;
            D0 = __builtin_amdgcn_mfma_f32_32x32x16_bf16(af, bfr[0], zz, 0, 0, 0);
            D1 = __builtin_amdgcn_mfma_f32_32x32x16_bf16(af, bfr[1], zz, 0, 0, 0);
            D2 = __builtin_amdgcn_mfma_f32_32x32x16_bf16(af, bfr[2], zz, 0, 0, 0);
            D3 = __builtin_amdgcn_mfma_f32_32x32x16_bf16(af, bfr[3], zz, 0, 0, 0);
        }
#pragma unroll
        for (int s = 0; s < 16; ++s) {
            const float n0r = a0.x * x0r - a0.y * x0i + D0[s], n0i = a0.x * x0i + a0.y * x0r + D2[s];
            const float n1r = a1.x * x1r - a1.y * x1i + D1[s], n1i = a1.x * x1i + a1.y * x1r + D3[s];
            x0r = n0r; x0i = n0i; x1r = n1r; x1i = n1i;
            D0[s] = x0r; D2[s] = x0i; D1[s] = x1r; D3[s] = x1i;
        }
        if (MODE != 0) {
#pragma unroll
            for (int s = 0; s < 16; ++s) {
                u32x2 w; w.x = cvt_pk_bf16(D0[s], D2[s]); w.y = cvt_pk_bf16(D1[s], D3[s]);
                *(LAS u32x2*)(xs + (s + 16 * h) * XS_STRIDE + c * 8) = w;
            }
            LDS_WAIT();
            const int chn = lane & 15, q = lane >> 4;
#pragma unroll
            for (int tb = 0; tb < 2; ++tb) {
                f32x4 y = (f32x4){0.f, 0.f, 0.f, 0.f};
#pragma unroll
                for (int kk = 0; kk < 4; ++kk) {
                    const bf16x8 xa = *(const LAS bf16x8*)(xs + (tb * 16 + chn) * XS_STRIDE + kk * 64 + q * 16);
                    y = __builtin_amdgcn_mfma_f32_16x16x32_bf16(cfr[kk], xa, y, 0, 0, 0);
                }
                {
                    const int row = rb0 + tb * SEQ + chn;
                    const u32x2 uu = uraw[tb];
                    const float z0 = gelu_tanh(y[0] + dsk4[0] * bflo(uu.x)), z1 = gelu_tanh(y[1] + dsk4[1] * bfhi(uu.x));
                    const float z2 = gelu_tanh(y[2] + dsk4[2] * bflo(uu.y)), z3 = gelu_tanh(y[3] + dsk4[3] * bfhi(uu.y));
                    u32x2 w; w.x = cvt_pk_bf16(z0, z1); w.y = cvt_pk_bf16(z2, z3);
                    *(u32x2*)(zb + (size_t)row * SSMW + g * 16 + 4 * q) = w;
                }
            }
            LDS_WAIT();
        }
        __builtin_amdgcn_sched_barrier(0);
    }
    }
    if (MODE == 0) {
        Eb[((size_t)(bh * NCH + ch) * 32 + g) * 64 + c] = make_float2(x0r, x0i); Eb[((size_t)(bh * NCH + ch) * 32 + g) * 64 + c + 32] = make_float2(x1r, x1i);
    }
    if (MODE == 1) {
        if (ch == NCH - 1) {
            float* ore = P.out + O_REP; float* oim = P.out + O_IMP; const size_t o = ((size_t)bh * 32 + g) * 64 + c;
            ore[o] = x0r; oim[o] = x0i; ore[o + 32] = x1r; oim[o + 32] = x1i;
        }
    }
}

__device__ __forceinline__ void conv_items(const Params& P, int it0, int it1, int stride) {
    unsigned char* ws = P.ws;
    const bf16_t* pbuf = (const bf16_t*)(ws + WS_P);
    bf16_t* mix = (bf16_t*)(ws + WS_MIX);
    const float* cw = P.in[21]; const float* scv = P.in[4];
        for (int it = it0; it < it1; it += stride) {
            const int row = it >> 6, c8 = (it & 63) * 8;
            const bf16_t* pr = pbuf + (size_t)row * PW;
            const u32x4 vc = *(const u32x4*)(pr + 1024 + c8), gb = *(const u32x4*)(pr + 512 + c8);
            float v0[8], v1[8], v2[8], gbf[8];
#pragma unroll
            for (int q = 0; q < 4; ++q) { v0[2 * q] = bflo(vc[q]); v0[2 * q + 1] = bfhi(vc[q]); gbf[2 * q] = bflo(gb[q]); gbf[2 * q + 1] = bfhi(gb[q]); }
            if (row < NPROMPT) {
                const int t = row & (SEQ - 1);
                if (t >= 1) { const u32x4 x1 = *(const u32x4*)(pr - PW + 1024 + c8);
#pragma unroll
                    for (int q = 0; q < 4; ++q) { v1[2 * q] = bflo(x1[q]); v1[2 * q + 1] = bfhi(x1[q]); } }
                else {
#pragma unroll
                    for (int q = 0; q < 8; ++q) v1[q] = 0.f; }
                if (t >= 2) { const u32x4 x2 = *(const u32x4*)(pr - 2 * PW + 1024 + c8);
#pragma unroll
                    for (int q = 0; q < 4; ++q) { v2[2 * q] = bflo(x2[q]); v2[2 * q + 1] = bfhi(x2[q]); } }
                else {
#pragma unroll
                    for (int q = 0; q < 8; ++q) v2[q] = 0.f; }
                if (t == SEQ - 1) { float* o = P.out + O_CVP + (size_t)(row >> 11) * 1024 + c8;
#pragma unroll
                    for (int q = 0; q < 8; ++q) { o[q] = v1[q]; o[512 + q] = v0[q]; } }
            } else {
                const int sb = row - NPROMPT; const float* bf = scv + (size_t)sb * 1024 + c8;
#pragma unroll
                for (int q = 0; q < 8; ++q) { v2[q] = bf[q]; v1[q] = bf[512 + q]; }
                float* o = P.out + O_CVS + (size_t)sb * 1024 + c8;
#pragma unroll
                for (int q = 0; q < 8; ++q) { o[q] = v1[q]; o[512 + q] = v0[q]; }
            }
            float co[8];
#pragma unroll
            for (int q = 0; q < 8; ++q) co[q] = gbf[q] * (cw[c8 + q] * v2[q] + cw[512 + c8 + q] * v1[q] + cw[1024 + c8 + q] * v0[q]);
            u32x4 w; w.x = pk2(co[0], co[1]); w.y = pk2(co[2], co[3]); w.z = pk2(co[4], co[5]); w.w = pk2(co[6], co[7]);
            *(u32x4*)(mix + (size_t)row * DM + 512 + c8) = w;
        }
}

__device__ __forceinline__ void conv_prompt_quads(const Params& P, int q0, int q1, int stride) {
    unsigned char* ws = P.ws;
    const bf16_t* pbuf = (const bf16_t*)(ws + WS_P);
    bf16_t* mix = (bf16_t*)(ws + WS_MIX);
    const float* cw = P.in[21];
    for (int qi = q0; qi < q1; qi += stride) {
        const int row = (qi >> 6) * 4, c8 = (qi & 63) * 8, t0 = row & (SEQ - 1);
        const bf16_t* pr = pbuf + (size_t)row * PW;
        const bf16_t* prm = t0 ? pr : pr + 2 * PW;
        u32x4 vv[6], gb[4];
        vv[0] = *(const u32x4*)(prm - 2 * PW + 1024 + c8); vv[1] = *(const u32x4*)(prm - PW + 1024 + c8);
#pragma unroll
        for (int r = 0; r < 4; ++r) { vv[2 + r] = *(const u32x4*)(pr + (size_t)r * PW + 1024 + c8); gb[r] = *(const u32x4*)(pr + (size_t)r * PW + 512 + c8); }
        float w0[8], w1[8], w2[8];
#pragma unroll
        for (int q = 0; q < 8; ++q) { w0[q] = cw[c8 + q]; w1[q] = cw[512 + c8 + q]; w2[q] = cw[1024 + c8 + q]; }
        float vf[6][8];
#pragma unroll
        for (int r = 0; r < 6; ++r)
#pragma unroll
            for (int q = 0; q < 4; ++q) { vf[r][2 * q] = bflo(vv[r][q]); vf[r][2 * q + 1] = bfhi(vv[r][q]); }
        if (t0 == 0) {
#pragma unroll
            for (int q = 0; q < 8; ++q) { vf[0][q] = 0.f; vf[1][q] = 0.f; }
        }
#pragma unroll
        for (int r = 0; r < 4; ++r) {
            float co[8];
#pragma unroll
            for (int q = 0; q < 4; ++q) {
                co[2 * q] = bflo(gb[r][q]) * (w0[2 * q] * vf[r][2 * q] + w1[2 * q] * vf[r + 1][2 * q] + w2[2 * q] * vf[r + 2][2 * q]);
                co[2 * q + 1] = bfhi(gb[r][q]) * (w0[2 * q + 1] * vf[r][2 * q + 1] + w1[2 * q + 1] * vf[r + 1][2 * q + 1] + w2[2 * q + 1] * vf[r + 2][2 * q + 1]);
            }
            u32x4 w; w.x = pk2(co[0], co[1]); w.y = pk2(co[2], co[3]); w.z = pk2(co[4], co[5]); w.w = pk2(co[6], co[7]);
            *(u32x4*)(mix + (size_t)(row + r) * DM + 512 + c8) = w;
        }
        if (t0 == SEQ - 4) {
            float* o = P.out + O_CVP + (size_t)(row >> 11) * 1024 + c8;
#pragma unroll
            for (int q = 0; q < 8; ++q) { o[q] = vf[4][q]; o[512 + q] = vf[5][q]; }
        }
    }
}

typedef __attribute__((address_space(1))) unsigned gu32;
#define XB_TMO      128
#define XB_XCNT(j)  (256  + 64 * (j))
#define XB_XSUB(j)  (1280 + 64 * (j))
#define XB_XGEN(j)  (2304 + 64 * (j))
#define XB_TOP      3328
#define XB_TOPGEN   3392
#define XCD_BAR_WORDS 3456
#define XB_SPIN_CAP (1u << 18)

__device__ __forceinline__ unsigned xb_ld(unsigned* p)              { return __hip_atomic_load(p, __ATOMIC_RELAXED, __HIP_MEMORY_SCOPE_AGENT); }
__device__ __forceinline__ unsigned xb_add(unsigned* p, unsigned v) { return __hip_atomic_fetch_add(p, v, __ATOMIC_RELAXED, __HIP_MEMORY_SCOPE_AGENT); }
__device__ __forceinline__ unsigned xb_xcc_id() { return (unsigned)__builtin_amdgcn_s_getreg((3 << 11) | 20) & 0xFu; }
#define XB_SPIN(cond, bar) do { unsigned _sp = 0; while (cond) { __builtin_amdgcn_s_sleep(1); \
    if ((++_sp & 255u) == 0u) { if (xb_ld(&(bar)[XB_TMO])) break; if (_sp > XB_SPIN_CAP) { atomicAdd(&(bar)[XB_TMO], 1u); break; } } } } while (0)

struct XcdBarrier {
    unsigned* bar; unsigned x;
    volatile LAS unsigned* st;
};

__device__ __forceinline__ XcdBarrier xcd_barrier_post(unsigned* bar, volatile LAS unsigned* st) {
    XcdBarrier b; b.bar = bar; b.x = xb_xcc_id(); b.st = st;
    if (threadIdx.x == 0) (void)xb_add(&bar[XB_XCNT(b.x)], 1u);
    return b;
}
__device__ __forceinline__ void xcd_barrier_complete(unsigned* bar, unsigned x, unsigned& nloc, unsigned& nx) {
    const unsigned G = gridDim.x * gridDim.y * gridDim.z;
    unsigned sum, cnt, mine, sp = 0u;
    for (;;) {
        sum = 0u; cnt = 0u; mine = 0u;
#pragma unroll
        for (unsigned j = 0; j < 16; ++j) { const unsigned c = xb_ld(&bar[XB_XCNT(j)]); sum += c; cnt += (c > 0u) ? 1u : 0u; mine = (j == x) ? c : mine; }
        if (sum == G) break;
        __builtin_amdgcn_s_sleep(1);
        if ((++sp & 255u) == 0u) { if (xb_ld(&bar[XB_TMO])) break; if (sp > XB_SPIN_CAP) { atomicAdd(&bar[XB_TMO], 1u); break; } }
    }
    nloc = mine > 0u ? mine : 1u; nx = cnt > 0u ? cnt : 1u;
}

__device__ __forceinline__ void xcd_barrier(const XcdBarrier& b) {
    asm volatile("s_waitcnt vmcnt(0)" ::: "memory");
    __syncthreads();
    if (threadIdx.x == 0) {
        unsigned* bar = b.bar;
        __builtin_amdgcn_s_waitcnt(0);
        unsigned nloc = b.st[0], nx = b.st[1];
        if (nloc == 0u) { xcd_barrier_complete(bar, b.x, nloc, nx); b.st[0] = nloc; b.st[1] = nx; }
        const unsigned old = xb_add(&bar[XB_XSUB(b.x)], 1u);
        const unsigned gen = old / nloc;
        if (old + 1u == (gen + 1u) * nloc) {
            __builtin_amdgcn_fence(__ATOMIC_RELEASE, "agent");
            asm volatile("s_waitcnt vmcnt(0)" ::: "memory");
            const unsigned og = xb_add(&bar[XB_TOP], 1u);
            const unsigned tg = og / nx;
            if (og + 1u == (tg + 1u) * nx) xb_add(&bar[XB_TOPGEN], 1u);
            else XB_SPIN(xb_ld(&bar[XB_TOPGEN]) == tg, bar);
            __builtin_amdgcn_fence(__ATOMIC_ACQUIRE, "agent");
            xb_add(&bar[XB_XGEN(b.x)], 1u);
            asm volatile("s_waitcnt vmcnt(0)" ::: "memory");
        } else {
            XB_SPIN(xb_ld(&bar[XB_XGEN(b.x)]) == gen, bar);
            __builtin_amdgcn_fence(__ATOMIC_ACQUIRE, "agent");
            asm volatile("s_waitcnt vmcnt(0)" ::: "memory");
        }
    }
    __syncthreads();
}


__global__ void __launch_bounds__(NTHREADS, 2) hymba_fwd(Params P) {
    extern __shared__ __attribute__((aligned(16))) unsigned char lds_raw[];
    LAS unsigned char* lds = (LAS unsigned char*)lds_raw;
    cg::grid_group grid = cg::this_grid();
    const int tid = threadIdx.x, lane = tid & 63, wave = __builtin_amdgcn_readfirstlane(tid >> 6);
    const int G = gridDim.x, bid = blockIdx.x;
    const int gw = bid * NWAVES + wave, NGW = G * NWAVES;
    unsigned char* ws = P.ws;
    float* ss = (float*)(ws + WS_SS);
    bf16_t* ab = (bf16_t*)(ws + WS_AB);
    bf16_t* act = (bf16_t*)(ws + WS_ACT);
    bf16_t* pbuf = (bf16_t*)(ws + WS_P);
    bf16_t* zbuf = (bf16_t*)(ws + WS_Z);
    bf16_t* mix = (bf16_t*)(ws + WS_MIX);
    const float* xp = P.in[0]; const float* xsamp = P.in[1];
    volatile LAS unsigned* bst = (volatile LAS unsigned*)(lds + 131072 + 512);
    if (tid < 2) bst[tid] = 0u;
    __syncthreads();
    XcdBarrier xbar = xcd_barrier_post((unsigned*)(ws + WS_BAR), bst);

    {
        LAS float* scr = (LAS float*)(lds + wave * 16384);
        transpose_matrix<1>(P.in[6], DM, DFF, (bf16_t*)(ws + WS_WGU1), P.in[5], scr, lane, gw, NGW);
        transpose_matrix<2>(P.in[7], DM, DFF, (bf16_t*)(ws + WS_WGU1), P.in[5], scr, lane, gw, NGW);
        for (int row0 = gw; row0 < MROWS; row0 += 2 * NGW) {
            const int row1 = row0 + NGW; const bool has1 = row1 < MROWS; const int r1c = has1 ? row1 : row0;
            const float* xr0 = row0 < NPROMPT ? xp + (size_t)row0 * DM : xsamp + (size_t)(row0 - NPROMPT) * DM;
            const float* xr1 = r1c < NPROMPT ? xp + (size_t)r1c * DM : xsamp + (size_t)(r1c - NPROMPT) * DM;
            f32x4 v0[4], v1[4];
#pragma unroll
            for (int j = 0; j < 4; ++j) { v0[j] = *(const f32x4*)(xr0 + j * 256 + lane * 4); v1[j] = *(const f32x4*)(xr1 + j * 256 + lane * 4); }
            float s0 = 0.f, s1 = 0.f;
#pragma unroll
            for (int j = 0; j < 4; ++j) {
                s0 += (v0[j][0] * v0[j][0] + v0[j][1] * v0[j][1]) + (v0[j][2] * v0[j][2] + v0[j][3] * v0[j][3]);
                s1 += (v1[j][0] * v1[j][0] + v1[j][1] * v1[j][1]) + (v1[j][2] * v1[j][2] + v1[j][3] * v1[j][3]);
                u32x2 w; w.x = cvt_pk_bf16(v0[j][0], v0[j][1]); w.y = cvt_pk_bf16(v0[j][2], v0[j][3]);
                *(u32x2*)(ab + (size_t)row0 * DM + j * 256 + lane * 4) = w;
                if (has1) { u32x2 w1; w1.x = cvt_pk_bf16(v1[j][0], v1[j][1]); w1.y = cvt_pk_bf16(v1[j][2], v1[j][3]); *(u32x2*)(ab + (size_t)row1 * DM + j * 256 + lane * 4) = w1; }
            }
            s0 = wave_sum(s0); s1 = wave_sum(s1);
            if (lane == 0) { ss[row0] = s0; if (has1) ss[row1] = s1; }
        }
        for (int i = bid * NTHREADS + tid; i < 3 * MP; i += G * NTHREADS) ss[MP + i] = 0.f;
        for (int i = bid * NTHREADS + tid; i < MP - MROWS; i += G * NTHREADS) ss[MROWS + i] = 1024.f;
        if (bid == 0 && tid < 256) ((unsigned*)(ws + WS_CNT))[tid] = 0u;
        {
            float2* t_ab = (float2*)(ws + WS_TAB + T_AB); float2* t_ab16 = (float2*)(ws + WS_TAB + T_AB16); float2* t_ab128 = (float2*)(ws + WS_TAB + T_AB128);
            const float* lre = P.in[11]; const float* lim = P.in[12]; const float* ldt = P.in[13];
            for (int i = bid * NTHREADS + tid; i < NG * NS; i += G * NTHREADS) {
                const int g = i >> 6;
                const float dt = expf(ldt[g]); const float lr = lre[i], li = lim[i];
                const float mag = expf(lr * dt); const float th = li * dt;
                float ar = mag * cosf(th), ai = mag * sinf(th);
                t_ab[i] = make_float2(ar, ai);
                float pr = ar, pi = ai;
#pragma unroll
                for (int k = 0; k < 7; ++k) { const float nr = pr * pr - pi * pi, ni = 2.f * pr * pi; pr = nr; pi = ni; if (k == 3) t_ab16[i] = make_float2(pr, pi); }
                t_ab128[i] = make_float2(pr, pi);
            }
            bf16_t* t_bf = (bf16_t*)(ws + WS_TAB + T_BF); bf16_t* t_cf = (bf16_t*)(ws + WS_TAB + T_CF);
            const float* bre = P.in[14]; const float* bim = P.in[15]; const float* cre = P.in[16]; const float* cim = P.in[17];
            for (int i = bid * NTHREADS + tid; i < NG * 4 * 64 * 8; i += G * NTHREADS) {
                const int j = i & 7, ln = (i >> 3) & 63, nt = (i >> 9) & 3, g = i >> 11;
                {
                    const int st = (nt & 1) * 32 + (ln & 31), part = nt >> 1, chn = 8 * (ln >> 5) + j;
                    const int gi = g * 64 + st;
                    const float dt = expf(ldt[g]); const float lr = lre[gi], li = lim[gi];
                    const float mag = expf(lr * dt); const float th = li * dt;
                    const float ar = mag * cosf(th), ai = mag * sinf(th);
                    const float den = lr * lr + li * li, nr = ar - 1.0f, ni = ai;
                    const float cr = (nr * lr + ni * li) / den, ci = (ni * lr - nr * li) / den;
                    const float br = bre[(size_t)gi * 16 + chn], bi = bim[(size_t)gi * 16 + chn];
                    const float v = part == 0 ? (cr * br - ci * bi) : (cr * bi + ci * br);
                    t_bf[i] = (bf16_t)f2bf(v);
                }
                {
                    const int kk = nt, k = kk * 32 + 8 * (ln >> 4) + j, chn = ln & 15, cc = k >> 2, sel = k & 3;
                    const int st = cc + ((sel >> 1) ? 32 : 0);
                    const size_t ci_ = ((size_t)g * 16 + chn) * 64 + st;
                    const float v = (sel & 1) ? -cim[ci_] : cre[ci_];
                    t_cf[i] = (bf16_t)f2bf(v);
                }
            }
        }
    }
    if (gridDim.y == 7) grid.sync();
    xcd_barrier(xbar);

    {
        pg8::Gemm g{ab, (const bf16_t*)(ws + WS_WGU1), MP, 2 * DFF, DM}; pg8::SplitOrder S; S.init(2 * DFF, DM, 1, G, bid);
        EpiGateUp E{act, ss};
        pg8::gemm_phase<EpiGateUp, pg8::SplitOrder, true, true>(lds, g, S, E, pg8::SplitCtx{nullptr, nullptr, 1});
        const int first_idle = (65 * 22) % G;
        if (bid >= first_idle) {
            LAS float* scr = (LAS float*)(lds + wave * 16384);
            const int w2 = (bid - first_idle) * NWAVES + wave, NW2 = (G - first_idle) * NWAVES;
            transpose_matrix<0>(P.in[8], DFF, DM, (bf16_t*)(ws + WS_WD1), nullptr, scr, lane, w2, NW2);
            transpose_matrix<3>(P.in[10], DM, PW, (bf16_t*)(ws + WS_WIN), P.in[9], scr, lane, w2, NW2);
            transpose_matrix<0>(P.in[19], SSMW, SSMW, (bf16_t*)(ws + WS_WGLU), nullptr, scr, lane, w2, NW2);
            transpose_matrix<0>(P.in[22], DM, DM, (bf16_t*)(ws + WS_WOUT), nullptr, scr, lane, w2, NW2);
        }
    }
    xcd_barrier(xbar);
    {
        pg8::Gemm g{act, (const bf16_t*)(ws + WS_WD1), MP, DM, DFF}; pg8::SplitOrder S; S.init(DM, DFF, 22, G, bid);
        EpiResid<false> E{xp, xsamp, ab, ss + MP, 0.5f};
        pg8::gemm_phase<EpiResid<false>, pg8::SplitOrder, true, true>(lds, g, S, E, pg8::SplitCtx{(float*)(ws + WS_PART), (unsigned*)(ws + WS_CNT), 22});
        sample_finalize<true, true, 22>((const float*)(ws + WS_PART), (unsigned*)(ws + WS_CNT), 22, 88, xsamp, P.out, ab, ss + MP, 0.5f, bid, wave, lane, tid, lds);
    }
    xcd_barrier(xbar);
    {
        pg8::Gemm g{ab, (const bf16_t*)(ws + WS_WIN), MP, PW, DM}; pg8::SplitOrder S; S.init(PW, DM, 1, G, bid, 1);
        EpiInProj E{pbuf, ss + MP};
        pg8::gemm_phase<EpiInProj, pg8::SplitOrder, true, true>(lds, g, S, E, pg8::SplitCtx{nullptr, nullptr, 1});
    }
    xcd_barrier(xbar);
    if (bid < 32) {
        pg8::Gemm g{ab, (const bf16_t*)(ws + WS_WIN), MP, PW, DM}; pg8::SplitOrder S; S.init(PW, DM, 4, G, bid, 2);
        EpiPartOnly E{};
        pg8::gemm_phase<EpiPartOnly, pg8::SplitOrder, true, true>(lds, g, S, E, pg8::SplitCtx{(float*)(ws + WS_PART), (unsigned*)(ws + WS_CNT) + 192, 4});
        sample_finalize_inproj<4>((const float*)(ws + WS_PART), (unsigned*)(ws + WS_CNT) + 192, 32, ss + MP, pbuf, bid, wave, lane, tid);
    } else {
        LAS unsigned char* xs = lds + wave * XS_BYTES;
        const int gw4 = (bid - 32) * NWAVES + wave, NGW4 = (G - 32) * NWAVES;
        for (int it = gw4; it < NBATCH * NCH * 32; it += NGW4) { if (((it >> 5) % NCH) != NCH - 1) ssm_item<0>(P, xs, lane, it); }
        conv_prompt_quads(P, (bid - 32) * NTHREADS + tid, (NPROMPT / 4) * 64, (G - 32) * NTHREADS);
    }
    xcd_barrier(xbar);
    {
        LAS unsigned char* xs = lds + wave * XS_BYTES;
        for (int it = gw; it < (NBATCH / 2) * NCH * 32 + (NSAMP / 32) * 32; it += NGW) {
            if (it < (NBATCH / 2) * NCH * 32) ssm_pair_item<1>(P, xs, lane, it); else ssm_item<2>(P, xs, lane, it - (NBATCH / 2) * NCH * 32);
        }
        conv_items(P, NPROMPT * 64 + bid * NTHREADS + tid, MROWS * 64, G * NTHREADS);
    }
    xcd_barrier(xbar);
    {
        pg8::Gemm g{zbuf, (const bf16_t*)(ws + WS_WGLU), MP, SSMW, SSMW}; pg8::SplitOrder S; S.init(SSMW, SSMW, 1, G, bid);
        EpiGlu E{zbuf, P.in[20], mix};
        pg8::gemm_phase<EpiGlu, pg8::SplitOrder, true, true>(lds, g, S, E, pg8::SplitCtx{nullptr, nullptr, 1});
        const int first_idle = (65 * 2) % G;
        if (bid >= first_idle) {
            LAS float* scr = (LAS float*)(lds + wave * 16384);
            const int w2 = (bid - first_idle) * NWAVES + wave, NW2 = (G - first_idle) * NWAVES;
            transpose_matrix<1>(P.in[24], DM, DFF, (bf16_t*)(ws + WS_WGU2), P.in[23], scr, lane, w2, NW2);
            transpose_matrix<2>(P.in[25], DM, DFF, (bf16_t*)(ws + WS_WGU2), P.in[23], scr, lane, w2, NW2);
        }
    }
    xcd_barrier(xbar);
    {
        pg8::Gemm g{mix, (const bf16_t*)(ws + WS_WOUT), MP, DM, DM}; pg8::SplitOrder S; S.init(DM, DM, 8, G, bid);
        EpiResid<false> E{xp, xsamp, ab, ss + 2 * MP, 1.0f};
        pg8::gemm_phase<EpiResid<false>, pg8::SplitOrder, true, true>(lds, g, S, E, pg8::SplitCtx{(float*)(ws + WS_PART), (unsigned*)(ws + WS_CNT) + 160, 8});
        sample_finalize<true, true, 8>((const float*)(ws + WS_PART), (unsigned*)(ws + WS_CNT) + 160, 8, 32, xsamp, P.out, ab, ss + 2 * MP, 1.0f, bid, wave, lane, tid, lds);
    }
    xcd_barrier(xbar);
    {
        pg8::Gemm g{ab, (const bf16_t*)(ws + WS_WGU2), MP, 2 * DFF, DM}; pg8::SplitOrder S; S.init(2 * DFF, DM, 1, G, bid);
        EpiGateUp E{act, ss + 2 * MP};
        pg8::gemm_phase<EpiGateUp, pg8::SplitOrder, true, true>(lds, g, S, E, pg8::SplitCtx{nullptr, nullptr, 1});
        const int first_idle = (65 * 22) % G;
        if (bid >= first_idle) {
            LAS float* scr = (LAS float*)(lds + wave * 16384);
            const int w2 = (bid - first_idle) * NWAVES + wave, NW2 = (G - first_idle) * NWAVES;
            transpose_matrix<0>(P.in[26], DFF, DM, (bf16_t*)(ws + WS_WD2), nullptr, scr, lane, w2, NW2);
        }
    }
    xcd_barrier(xbar);
    {
        pg8::Gemm g{act, (const bf16_t*)(ws + WS_WD2), MP, DM, DFF}; pg8::SplitOrder S; S.init(DM, DFF, 22, G, bid);
        EpiFinal E{P.out, ab, ss + 3 * MP, (unsigned*)(ws + WS_CNT) + 64, P.in[27], 0.5f};
        pg8::gemm_phase<EpiFinal, pg8::SplitOrder, true, true>(lds, g, S, E, pg8::SplitCtx{(float*)(ws + WS_PART), (unsigned*)(ws + WS_CNT) + 32, 22});
        sample_finalize_norm<22>((const float*)(ws + WS_PART), (unsigned*)(ws + WS_CNT) + 32, 22, 88, P.out, ab, P.in[27], 0.5f, bid, wave, lane, tid, lds);
    }
}

extern "C" void kernel_launch(void* const* d_in, const int* in_sizes, int n_in, void* d_out, int out_size, void* d_ws, size_t ws_size, hipStream_t stream) {
    static int grid_blocks = 0;
    if (grid_blocks == 0) {
        if (n_in != 28 || ws_size < WS_END) { fprintf(stderr, "kernel_launch: unexpected n_in %d / ws %zu\n", n_in, ws_size); grid_blocks = -1; return; }
        int dev = 0, cus = 0, per_cu = 0;
        hipGetDevice(&dev);
        hipDeviceGetAttribute(&cus, hipDeviceAttributeMultiprocessorCount, dev);
        if (hipFuncSetAttribute((const void*)hymba_fwd, hipFuncAttributeMaxDynamicSharedMemorySize, LDS_BYTES) != hipSuccess) { fprintf(stderr, "kernel_launch: hipFuncSetAttribute failed\n"); grid_blocks = -1; return; }
        if (hipOccupancyMaxActiveBlocksPerMultiprocessor(&per_cu, (const void*)hymba_fwd, NTHREADS, LDS_BYTES) != hipSuccess || per_cu < 1) { fprintf(stderr, "kernel_launch: occupancy query gave %d\n", per_cu); per_cu = 1; }
        (void)hipGetLastError();
        grid_blocks = cus * 1;
        fprintf(stderr, "kernel_launch: cus %d per_cu %d grid %d\n", cus, per_cu, grid_blocks);
    }
    if (grid_blocks < 0) return;
    Params p{};
    for (int i = 0; i < 28; ++i) p.in[i] = (const float*)d_in[i];
    p.out = (float*)d_out; p.ws = (unsigned char*)d_ws;
    if (hipMemsetAsync((char*)d_ws + WS_BAR, 0, 16384, stream) != hipSuccess) { fprintf(stderr, "kernel_launch: memset failed\n"); return; }
    void* args[] = {&p};
    hipError_t e = hipLaunchCooperativeKernel((const void*)hymba_fwd, dim3(grid_blocks), dim3(NTHREADS), args, LDS_BYTES, stream);
    if (e != hipSuccess) fprintf(stderr, "cooperative launch failed: %s (grid %d)\n", hipGetErrorString(e), grid_blocks);
}
```
